# Optimizing an MI355X kernel written in HIP

```python
import jax, jax.numpy as jnp
from jax import lax
import numpy as np

D_MODEL = 1024
BATCH = 16
SEQ = 2048
DEPTH = 2

GRID_W = 64
CTX_LEN = 256
N_MIXERS = 2
HEAD_DIM = 64
DA_HEADS = D_MODEL // (2 * HEAD_DIM)
NA_HEADS = D_MODEL // HEAD_DIM
NA_WIN_ROWS = 8
NA_WIN_COLS = 16
D_FF = ((8 * D_MODEL + 3 * 256 - 1) // (3 * 256)) * 256
ROPE_THETA = 10000.0
Q_BLOCK = 128
EPS = 1e-6

kernel_name = "hybrid_diffattn_natten_prefix_dit"


def rmsnorm(x, g):
    xf = x.astype(jnp.float32)
    y = xf * lax.rsqrt(jnp.mean(xf * xf, axis=-1, keepdims=True) + EPS)
    return (y * g.astype(jnp.float32)).astype(x.dtype)


def adaln(cond, w, b):
    mod = jax.nn.silu(cond) @ w + b
    return jnp.split(mod, 6, axis=-1)


def modulate(xn, shift, scale):
    return xn * (1 + scale) + shift


def swiglu(h, w_gate_up, w_down):
    gu = h @ w_gate_up
    g, u = jnp.split(gu, 2, axis=-1)
    return (jax.nn.silu(g) * u) @ w_down


def axial_rope_tables(n):
    t = jnp.arange(n)
    row = (t // GRID_W).astype(jnp.float32)
    col = (t % GRID_W).astype(jnp.float32)
    half = HEAD_DIM // 2
    freqs = 1.0 / (ROPE_THETA ** (jnp.arange(0, half, 2, dtype=jnp.float32) / half))
    ar = row[:, None] * freqs
    ac = col[:, None] * freqs
    ang = jnp.concatenate([ar, ar, ac, ac], axis=-1)
    return jnp.cos(ang), jnp.sin(ang)


def rotate_half(x):
    x1, x2 = jnp.split(x, 2, axis=-1)
    return jnp.concatenate([-x2, x1], axis=-1)


def apply_rope(t, cos, sin):
    half = t.shape[-1] // 2
    rot = jnp.concatenate([rotate_half(t[..., :half]), rotate_half(t[..., half:])], axis=-1)
    shape = (t.shape[1],) + (1,) * (t.ndim - 3) + (t.shape[-1],)
    return t * cos.reshape(shape).astype(t.dtype) + rot * sin.reshape(shape).astype(t.dtype)


def diff_attention(h_lat, h_ctx, wqkv, lq1, lk1, lq2, lk2, subln, wo, lam_init, need_ctx_out):
    B, N, _ = h_lat.shape
    L = h_ctx.shape[1]
    scale = HEAD_DIM ** -0.5

    def proj(h):
        n = h.shape[1]
        q, k, v = jnp.split(h @ wqkv, 3, axis=-1)
        return (q.reshape(B, n, DA_HEADS, 2, HEAD_DIM),
                k.reshape(B, n, DA_HEADS, 2, HEAD_DIM),
                v.reshape(B, n, DA_HEADS, 2 * HEAD_DIM))

    q_l, k_l, v_l = proj(h_lat)
    q_c, k_c, v_c = proj(h_ctx)
    cos, sin = axial_rope_tables(N)
    q_l = apply_rope(q_l, cos, sin)
    k_l = apply_rope(k_l, cos, sin)

    f32 = jnp.float32
    lam = (jnp.exp(jnp.sum(lq1.astype(f32) * lk1.astype(f32)))
           - jnp.exp(jnp.sum(lq2.astype(f32) * lk2.astype(f32))) + lam_init)

    def attend(q_blk, k, v):
        s = jnp.einsum('bqhmd,bkhmd->bhmqk', q_blk, k).astype(f32) * scale
        p = jax.nn.softmax(s, axis=-1)
        p = p[:, :, 0] - lam * p[:, :, 1]
        return jnp.einsum('bhqk,bkhe->bqhe', p.astype(v.dtype), v)

    k_all = jnp.concatenate([k_c, k_l], axis=1)
    v_all = jnp.concatenate([v_c, v_l], axis=1)
    nblk = N // Q_BLOCK
    q_blocks = q_l.reshape(B, nblk, Q_BLOCK, DA_HEADS, 2, HEAD_DIM).transpose(1, 0, 2, 3, 4, 5)
    o_l = lax.map(lambda qb: attend(qb, k_all, v_all), q_blocks)
    o_l = o_l.transpose(1, 0, 2, 3, 4).reshape(B, N, DA_HEADS, 2 * HEAD_DIM)

    def finish(o, n):
        o = rmsnorm(o, subln) * (1.0 - lam_init)
        return o.reshape(B, n, D_MODEL) @ wo

    y_l = finish(o_l, N)
    y_c = finish(attend(q_c, k_c, v_c), L) if need_ctx_out else None
    return y_l, y_c


def neighbourhood_attention(h_lat, h_ctx, wqkv, rpb, wo, need_ctx_out):
    B, N, _ = h_lat.shape
    L = h_ctx.shape[1]
    rows = N // GRID_W
    wr = min(NA_WIN_ROWS, rows)
    scale = HEAD_DIM ** -0.5
    f32 = jnp.float32

    def proj(h):
        n = h.shape[1]
        q, k, v = jnp.split(h @ wqkv, 3, axis=-1)
        return tuple(t.reshape(B, n, NA_HEADS, HEAD_DIM) for t in (q, k, v))

    q_l, k_l, v_l = proj(h_lat)
    q_c, k_c, v_c = proj(h_ctx)
    kg = k_l.reshape(B, rows, GRID_W, NA_HEADS, HEAD_DIM)
    vg = v_l.reshape(B, rows, GRID_W, NA_HEADS, HEAD_DIM)
    qg = q_l.reshape(B, rows, GRID_W, NA_HEADS, HEAD_DIM).transpose(1, 0, 2, 3, 4)

    qc = np.arange(GRID_W)
    col_start = np.clip(qc - NA_WIN_COLS // 2, 0, GRID_W - NA_WIN_COLS)
    col_mask = (qc[None, :] >= col_start[:, None]) & (qc[None, :] < col_start[:, None] + NA_WIN_COLS)
    dc_idx = np.clip(qc[None, :] - qc[:, None] + NA_WIN_COLS - 1, 0, 2 * NA_WIN_COLS - 2)
    rpb_cols = rpb[:, :, dc_idx]
    col_mask = jnp.asarray(col_mask)[None, None, :, None, :]

    def row_block(args):
        q_row, r = args
        rs = jnp.clip(r - NA_WIN_ROWS // 2, 0, rows - wr)
        kb = lax.dynamic_slice_in_dim(kg, rs, wr, axis=1)
        vb = lax.dynamic_slice_in_dim(vg, rs, wr, axis=1)
        dr_idx = rs + jnp.arange(wr) - r + NA_WIN_ROWS - 1
        bias = rpb_cols[:, dr_idx].transpose(0, 2, 1, 3)
        s_band = jnp.einsum('bqhd,brkhd->bhqrk', q_row, kb).astype(f32) * scale + bias.astype(f32)
        s_band = jnp.where(col_mask, s_band, -jnp.inf)
        s_ctx = jnp.einsum('bqhd,bchd->bhqc', q_row, k_c).astype(f32) * scale
        s = jnp.concatenate([s_band.reshape(B, NA_HEADS, GRID_W, wr * GRID_W), s_ctx], axis=-1)
        p = jax.nn.softmax(s, axis=-1).astype(v_c.dtype)
        p_band = p[..., :wr * GRID_W].reshape(B, NA_HEADS, GRID_W, wr, GRID_W)
        p_ctx = p[..., wr * GRID_W:]
        return (jnp.einsum('bhqrk,brkhd->bqhd', p_band, vb)
                + jnp.einsum('bhqc,bchd->bqhd', p_ctx, v_c))

    o_l = lax.map(row_block, (qg, jnp.arange(rows)))
    y_l = o_l.transpose(1, 0, 2, 3, 4).reshape(B, N, D_MODEL) @ wo

    y_c = None
    if need_ctx_out:
        s = jnp.einsum('bqhd,bkhd->bhqk', q_c, k_c).astype(f32) * scale
        p = jax.nn.softmax(s, axis=-1).astype(v_c.dtype)
        y_c = jnp.einsum('bhqk,bkhd->bqhd', p, v_c).reshape(B, L, D_MODEL) @ wo
    return y_l, y_c


def setup_inputs(seed: int = 0) -> dict:
    key = jax.random.key(seed)
    ks = jax.random.split(key, 24)
    D, F = D_MODEL, D_FF
    n_a = (DEPTH + 1) // 2
    n_b = DEPTH // 2
    nrm = jax.random.normal
    f32 = jnp.float32
    return {
        "x": nrm(ks[0], (BATCH, SEQ, D), f32),
        "c": nrm(ks[1], (BATCH, D), f32),
        "ctx": nrm(ks[2], (BATCH, CTX_LEN, D), f32),
        "c_ctx": nrm(ks[3], (D,), f32),
        "ada_w": nrm(ks[4], (DEPTH, D, 6 * D), f32) * D ** -0.5,
        "ada_b": nrm(ks[5], (DEPTH, 6 * D), f32) * 0.01,
        "norm_mix": 1.0 + 0.02 * nrm(ks[6], (DEPTH, D), f32),
        "norm_ffn": 1.0 + 0.02 * nrm(ks[7], (DEPTH, D), f32),
        "da_wqkv": nrm(ks[8], (n_a, D, 3 * D), f32) * D ** -0.5,
        "da_lambda_q1": nrm(ks[9], (n_a, HEAD_DIM), f32) * 0.1,
        "da_lambda_k1": nrm(ks[10], (n_a, HEAD_DIM), f32) * 0.1,
        "da_lambda_q2": nrm(ks[11], (n_a, HEAD_DIM), f32) * 0.1,
        "da_lambda_k2": nrm(ks[12], (n_a, HEAD_DIM), f32) * 0.1,
        "da_subln": 1.0 + 0.02 * nrm(ks[13], (n_a, 2 * HEAD_DIM), f32),
        "da_wo": nrm(ks[14], (n_a, D, D), f32) * D ** -0.5,
        "na_wqkv": nrm(ks[15], (n_b, D, 3 * D), f32) * D ** -0.5,
        "na_rpb": nrm(ks[16], (n_b, NA_HEADS, 2 * NA_WIN_ROWS - 1, 2 * NA_WIN_COLS - 1), f32) * 0.02,
        "na_wo": nrm(ks[17], (n_b, D, D), f32) * D ** -0.5,
        "ffn_w_gate_up": nrm(ks[18], (DEPTH, D, 2 * F), f32) * D ** -0.5,
        "ffn_w_down": nrm(ks[19], (DEPTH, F, D), f32) * F ** -0.5,
        "norm_final": 1.0 + 0.02 * nrm(ks[20], (D,), f32),
    }


def reference(x, c, ctx, c_ctx, ada_w, ada_b, norm_mix, norm_ffn,
              da_wqkv, da_lambda_q1, da_lambda_k1, da_lambda_q2, da_lambda_k2, da_subln, da_wo,
              na_wqkv, na_rpb, na_wo, ffn_w_gate_up, ffn_w_down, norm_final):
    h, hc = x, ctx
    for i in range(DEPTH):
        last = i == DEPTH - 1
        sh_m, sc_m, g_m, sh_f, sc_f, g_f = (t[:, None, :] for t in adaln(c, ada_w[i], ada_b[i]))
        csh_m, csc_m, cg_m, csh_f, csc_f, cg_f = adaln(c_ctx, ada_w[i], ada_b[i])

        xn = modulate(rmsnorm(h, norm_mix[i]), sh_m, sc_m)
        xc = modulate(rmsnorm(hc, norm_mix[i]), csh_m, csc_m)
        j = i // N_MIXERS
        if i % N_MIXERS == 0:
            lam_init = 0.8 - 0.6 * float(np.exp(-0.3 * i))
            y, yc = diff_attention(xn, xc, da_wqkv[j], da_lambda_q1[j], da_lambda_k1[j],
                                   da_lambda_q2[j], da_lambda_k2[j], da_subln[j], da_wo[j],
                                   lam_init, not last)
        else:
            y, yc = neighbourhood_attention(xn, xc, na_wqkv[j], na_rpb[j], na_wo[j], not last)

        h = h + g_m * y
        h = h + g_f * swiglu(modulate(rmsnorm(h, norm_ffn[i]), sh_f, sc_f),
                             ffn_w_gate_up[i], ffn_w_down[i])
        if not last:
            hc = hc + cg_m * yc
            hc = hc + cg_f * swiglu(modulate(rmsnorm(hc, norm_ffn[i]), csh_f, csc_f),
                                    ffn_w_gate_up[i], ffn_w_down[i])
    return rmsnorm(h, norm_final)
```

```cpp
#include <hip/hip_runtime.h>
#include <hip/hip_cooperative_groups.h>
#include <cstdio>
namespace cg = cooperative_groups;

typedef unsigned short u16;
typedef __attribute__((ext_vector_type(8))) short bf16x8;
typedef __attribute__((ext_vector_type(4))) short s16x4;
typedef __attribute__((ext_vector_type(16))) float f32x16;
typedef __attribute__((ext_vector_type(2))) __bf16 bf2_t;
typedef __attribute__((ext_vector_type(2))) float f2_t;

#define DI __device__ __forceinline__
#define MFMA(a, b, c) __builtin_amdgcn_mfma_f32_32x32x16_bf16((a), (b), (c), 0, 0, 0)

#ifndef ONLYPH
#define ONLYPH -1
#endif
#define PHON(x) (ONLYPH < 0 || ONLYPH == (x))
#ifndef TNQ
#define TNQ 128
#endif
#ifndef TNR1
#define TNR1 128
#endif
#ifndef DUP_PHASE
#define DUP_PHASE -1
#endif
#ifndef MULTI_LAUNCH
#define MULTI_LAUNCH 0
#endif

constexpr int DM = 1024;
constexpr int TOKB = 2304;
constexpr int MTOT = 16 * TOKB;
constexpr int FF = 2816;
constexpr float L2E = 1.4426950408889634f;
constexpr int RPB_OFF = 135168 + 256;
constexpr int SMEM_BYTES = 135168 + 256 + 7680 + 256;

struct Params {
  const float *x, *c, *ctx, *c_ctx, *ada_w, *ada_b, *norm_mix, *norm_ffn;
  const float *da_wqkv, *lq1, *lk1, *lq2, *lk2, *subln, *da_wo, *na_wqkv, *rpb, *na_wo, *w_gu, *w_dn, *norm_final;
  float* out;
  u16 *wqkv_t, *wo_t, *wgu_t, *wd_t;
  float *mod, *tab, *lam, *hc;
  unsigned* bar;
  int* cnt;
  u16 *xn, *q, *k, *vt, *act;
};

DI int lane_id_() { return (int)__builtin_amdgcn_mbcnt_hi(~0u, __builtin_amdgcn_mbcnt_lo(~0u, 0u)); }
#define TIDX (wv * 64 + lane_id_())

DI unsigned pk2(float a, float b) {
  f2_t v = {a, b};
  bf2_t r = __builtin_convertvector(v, bf2_t);
  return __builtin_bit_cast(unsigned, r);
}
DI float silu_f(float v) { return v / (1.f + __expf(-v)); }

DI void conv_tile(const int wv, const float* __restrict__ src, int K, int N, u16* __restrict__ dst, int perm, int tile, char* smem) {
  float* ts = (float*)smem;
  const int tid = TIDX;
  const int nkt = K >> 6;
  const int kt = tile % nkt, ntile = tile / nkt;
  const int k0 = kt * 64, n0 = ntile * 64;
  __syncthreads();
#pragma unroll
  for (int i = 0; i < 8; ++i) {
    int kk = wv + 8 * i, n = lane_id_();
    ts[kk * 65 + n] = src[(size_t)(k0 + kk) * N + n0 + n];
  }
  __syncthreads();
  const int n = tid >> 3, kc = tid & 7;
  float v[8];
#pragma unroll
  for (int j = 0; j < 8; ++j) v[j] = ts[(kc * 8 + j) * 65 + n];
  int nn = n0 + n;
  if (perm) {
    int half = nn >= FF ? 1 : 0;
    int cc = nn - half * FF;
    nn = (cc >> 4) * 32 + half * 16 + (cc & 15);
  }
  uint4 o;
  o.x = pk2(v[0], v[1]); o.y = pk2(v[2], v[3]); o.z = pk2(v[4], v[5]); o.w = pk2(v[6], v[7]);
  *(uint4*)(dst + (size_t)nn * K + k0 + kc * 8) = o;
}

DI void mod_item(const int wv, const Params& p, int item, char* smem) {
  const int l = item / 96, n0 = (item % 96) * 64;
  float* sc = (float*)smem;
  float* red = (float*)(smem + 81920);
  const int lane = lane_id_(), w = wv, tid = w * 64 + lane;
  __syncthreads();
  for (int e = tid; e < 17 * 1024; e += 512) {
    int r = e >> 10, kk = e & 1023;
    float v = (r < 16) ? p.c[r * 1024 + kk] : p.c_ctx[kk];
    sc[kk * 20 + r] = silu_f(v);
  }
  __syncthreads();
  float acc[17];
#pragma unroll
  for (int r = 0; r < 17; ++r) acc[r] = 0.f;
  const float* wp = p.ada_w + ((size_t)l * 1024 + w * 128) * 6144 + n0 + lane;
#pragma unroll 16
  for (int kk = 0; kk < 128; ++kk) {
    float wv = wp[(size_t)kk * 6144];
    const float4* s4 = (const float4*)(sc + (w * 128 + kk) * 20);
    float4 a0 = s4[0], a1 = s4[1], a2 = s4[2], a3 = s4[3];
    float a16 = sc[(w * 128 + kk) * 20 + 16];
    acc[0] += a0.x * wv; acc[1] += a0.y * wv; acc[2] += a0.z * wv; acc[3] += a0.w * wv;
    acc[4] += a1.x * wv; acc[5] += a1.y * wv; acc[6] += a1.z * wv; acc[7] += a1.w * wv;
    acc[8] += a2.x * wv; acc[9] += a2.y * wv; acc[10] += a2.z * wv; acc[11] += a2.w * wv;
    acc[12] += a3.x * wv; acc[13] += a3.y * wv; acc[14] += a3.z * wv; acc[15] += a3.w * wv;
    acc[16] += a16 * wv;
  }
#pragma unroll
  for (int r = 0; r < 17; ++r) red[(w * 17 + r) * 64 + lane] = acc[r];
  __syncthreads();
  for (int e = tid; e < 17 * 64; e += 512) {
    int r = e >> 6, nl = e & 63;
    float s = 0.f;
#pragma unroll
    for (int ww = 0; ww < 8; ++ww) s += red[(ww * 17 + r) * 64 + nl];
    s += p.ada_b[l * 6144 + n0 + nl];
    p.mod[((size_t)l * 17 + r) * 6144 + n0 + nl] = s;
  }
}

DI void table_item(const int wv, const Params& p) {
  const int tid = TIDX;
  for (int e = tid; e < 3456; e += 512) p.bar[e] = 0u;
  if (tid < 128) p.cnt[tid] = 0;
  for (int e = tid; e < 1024; e += 512) {
    int pos = e >> 4, f = e & 15;
    float freq = powf(10000.f, -(float)f / 16.f);
    float ang = (float)pos * freq;
    float sn, cs;
    sincosf(ang, &sn, &cs);
    p.tab[e * 2] = cs;
    p.tab[e * 2 + 1] = sn;
  }
  if (tid < 64) {
    float a = p.lq1[tid] * p.lk1[tid];
    float b = p.lq2[tid] * p.lk2[tid];
#pragma unroll
    for (int o = 32; o > 0; o >>= 1) { a += __shfl_xor(a, o); b += __shfl_xor(b, o); }
    if (tid == 0) p.lam[0] = expf(a) - expf(b) + 0.2f;
  }
}

DI void conv_list_tile(const int wv, const Params& p, int t, char* smem) {
  const int l = t / 3136;
  t -= l * 3136;
  if (t < 768) {
    conv_tile(wv, l == 0 ? p.da_wqkv : p.na_wqkv, 1024, 3072, p.wqkv_t + (size_t)l * 3072 * 1024, 0, t, smem);
  } else if (t < 1024) {
    conv_tile(wv, l == 0 ? p.da_wo : p.na_wo, 1024, 1024, p.wo_t + (size_t)l * 1024 * 1024, 0, t - 768, smem);
  } else if (t < 2432) {
    conv_tile(wv, p.w_gu + (size_t)l * 1024 * 5632, 1024, 5632, p.wgu_t + (size_t)l * 5632 * 1024, 1, t - 1024, smem);
  } else {
    conv_tile(wv, p.w_dn + (size_t)l * FF * 1024, FF, 1024, p.wd_t + (size_t)l * 1024 * FF, 0, t - 2432, smem);
  }
}

DI void phase_prep(const int wv, const Params& p, char* smem) {
  const int total = 192 + 1 + 1024;
  for (int it = blockIdx.x; it < total; it += gridDim.x) {
    if (it < 192) { mod_item(wv, p, it, smem); continue; }
    if (it == 192) { table_item(wv, p); continue; }
    conv_list_tile(wv, p, it - 193, smem);
  }
}

struct NormSpec {
  int kind;
  const float* gw;
  int layer, ch_shift, ch_scale;
};
DI void norm_one_row(const Params& p, const NormSpec& ns, int row, int lane) {
  const int b = row / TOKB, j = row - b * TOKB;
  float* src = (j < 256) ? p.hc + ((size_t)b * 256 + j) * DM : p.out + ((size_t)b * 2048 + (j - 256)) * DM;
  float4 v[4];
  float ss = 0.f;
#pragma unroll
  for (int i = 0; i < 4; ++i) {
    v[i] = *(const float4*)(src + i * 256 + lane * 4);
    ss += v[i].x * v[i].x + v[i].y * v[i].y + v[i].z * v[i].z + v[i].w * v[i].w;
  }
#pragma unroll
  for (int o = 32; o > 0; o >>= 1) ss += __shfl_xor(ss, o);
  const float r = rsqrtf(ss * (1.f / 1024.f) + 1e-6f);
  if (ns.kind == 1) {
    const int mr = (j < 256) ? 16 : b;
    const float* sh = p.mod + ((size_t)ns.layer * 17 + mr) * 6144 + ns.ch_shift * 1024;
    const float* sc = p.mod + ((size_t)ns.layer * 17 + mr) * 6144 + ns.ch_scale * 1024;
    u16* dst = p.xn + (size_t)row * DM;
#pragma unroll
    for (int i = 0; i < 4; ++i) {
      const int n = i * 256 + lane * 4;
      float4 g = *(const float4*)(ns.gw + n);
      float4 s1 = *(const float4*)(sc + n);
      float4 s0 = *(const float4*)(sh + n);
      float y0 = v[i].x * r * g.x * (1.f + s1.x) + s0.x;
      float y1 = v[i].y * r * g.y * (1.f + s1.y) + s0.y;
      float y2 = v[i].z * r * g.z * (1.f + s1.z) + s0.z;
      float y3 = v[i].w * r * g.w * (1.f + s1.w) + s0.w;
      uint2 o; o.x = pk2(y0, y1); o.y = pk2(y2, y3);
      *(uint2*)(dst + n) = o;
    }
  } else {
#pragma unroll
    for (int i = 0; i < 4; ++i) {
      const int n = i * 256 + lane * 4;
      float4 g = *(const float4*)(ns.gw + n);
      float4 o;
      o.x = v[i].x * r * g.x; o.y = v[i].y * r * g.y; o.z = v[i].z * r * g.z; o.w = v[i].w * r * g.w;
      *(float4*)(src + n) = o;
    }
  }
}

DI void phase_norm(const int wv, const Params& p, const float* __restrict__ lat, const float* __restrict__ cx, const float* __restrict__ gw,
                   int layer, int ch_shift, int ch_scale, bool lat_only) {
  const int lane = lane_id_(), w = wv;
  for (int row0 = blockIdx.x * 32 + w * 4; row0 < MTOT; row0 += gridDim.x * 32) {
    const int b = row0 / TOKB, j = row0 - b * TOKB;
    if (lat_only && j < 256) continue;
    const float* src = (j < 256) ? cx + ((size_t)b * 256 + j) * DM : lat + ((size_t)b * 2048 + (j - 256)) * DM;
    const int mr = (j < 256) ? 16 : b;
    const float* sh = p.mod + ((size_t)layer * 17 + mr) * 6144 + ch_shift * 1024;
    const float* sc = p.mod + ((size_t)layer * 17 + mr) * 6144 + ch_scale * 1024;
    float4 v0[4], v1[4], v2[4], v3[4];
#pragma unroll
    for (int i = 0; i < 4; ++i) v0[i] = *(const float4*)(src + i * 256 + lane * 4);
#pragma unroll
    for (int i = 0; i < 4; ++i) v1[i] = *(const float4*)(src + DM + i * 256 + lane * 4);
#pragma unroll
    for (int i = 0; i < 4; ++i) v2[i] = *(const float4*)(src + 2 * DM + i * 256 + lane * 4);
#pragma unroll
    for (int i = 0; i < 4; ++i) v3[i] = *(const float4*)(src + 3 * DM + i * 256 + lane * 4);
    float s0 = 0.f, s1 = 0.f, s2 = 0.f, s3 = 0.f;
#pragma unroll
    for (int i = 0; i < 4; ++i) {
      s0 += v0[i].x * v0[i].x + v0[i].y * v0[i].y + v0[i].z * v0[i].z + v0[i].w * v0[i].w;
      s1 += v1[i].x * v1[i].x + v1[i].y * v1[i].y + v1[i].z * v1[i].z + v1[i].w * v1[i].w;
      s2 += v2[i].x * v2[i].x + v2[i].y * v2[i].y + v2[i].z * v2[i].z + v2[i].w * v2[i].w;
      s3 += v3[i].x * v3[i].x + v3[i].y * v3[i].y + v3[i].z * v3[i].z + v3[i].w * v3[i].w;
    }
#pragma unroll
    for (int o = 32; o > 0; o >>= 1) { s0 += __shfl_xor(s0, o); s1 += __shfl_xor(s1, o); s2 += __shfl_xor(s2, o); s3 += __shfl_xor(s3, o); }
    const float r0 = rsqrtf(s0 * (1.f / 1024.f) + 1e-6f), r1 = rsqrtf(s1 * (1.f / 1024.f) + 1e-6f);
    const float r2 = rsqrtf(s2 * (1.f / 1024.f) + 1e-6f), r3 = rsqrtf(s3 * (1.f / 1024.f) + 1e-6f);
    u16* dst = p.xn + (size_t)row0 * DM;
#pragma unroll
    for (int i = 0; i < 4; ++i) {
      const int n = i * 256 + lane * 4;
      const float4 g = *(const float4*)(gw + n);
      const float4 c1 = *(const float4*)(sc + n);
      const float4 c0 = *(const float4*)(sh + n);
      const float m0 = g.x * (1.f + c1.x), m1 = g.y * (1.f + c1.y), m2 = g.z * (1.f + c1.z), m3 = g.w * (1.f + c1.w);
      uint2 o;
#define NROW(v_, r_, k_)                                                                   \
      o.x = pk2(v_[i].x * r_ * m0 + c0.x, v_[i].y * r_ * m1 + c0.y);                        \
      o.y = pk2(v_[i].z * r_ * m2 + c0.z, v_[i].w * r_ * m3 + c0.w);                        \
      *(uint2*)(dst + (k_) * DM + n) = o;
      NROW(v0, r0, 0) NROW(v1, r1, 1) NROW(v2, r2, 2) NROW(v3, r3, 3)
#undef NROW
    }
  }
}

DI void phase_final_norm(const int wv, const Params& p) {
  const int lane = lane_id_(), w = wv;
  for (int row0 = blockIdx.x * 16 + w * 2; row0 < 32768; row0 += gridDim.x * 16) {
    float* src = p.out + (size_t)row0 * DM;
    float4 va[4], vb[4];
#pragma unroll
    for (int i = 0; i < 4; ++i) va[i] = *(const float4*)(src + i * 256 + lane * 4);
#pragma unroll
    for (int i = 0; i < 4; ++i) vb[i] = *(const float4*)(src + DM + i * 256 + lane * 4);
    float sa = 0.f, sb2 = 0.f;
#pragma unroll
    for (int i = 0; i < 4; ++i) {
      sa += va[i].x * va[i].x + va[i].y * va[i].y + va[i].z * va[i].z + va[i].w * va[i].w;
      sb2 += vb[i].x * vb[i].x + vb[i].y * vb[i].y + vb[i].z * vb[i].z + vb[i].w * vb[i].w;
    }
#pragma unroll
    for (int o = 32; o > 0; o >>= 1) { sa += __shfl_xor(sa, o); sb2 += __shfl_xor(sb2, o); }
    const float ra = rsqrtf(sa * (1.f / 1024.f) + 1e-6f);
    const float rb = rsqrtf(sb2 * (1.f / 1024.f) + 1e-6f);
#pragma unroll
    for (int i = 0; i < 4; ++i) {
      const int n = i * 256 + lane * 4;
      const float4 g = *(const float4*)(p.norm_final + n);
      float4 o;
      o.x = va[i].x * ra * g.x; o.y = va[i].y * ra * g.y; o.z = va[i].z * ra * g.z; o.w = va[i].w * ra * g.w;
      *(float4*)(src + n) = o;
      o.x = vb[i].x * rb * g.x; o.y = vb[i].y * rb * g.y; o.z = vb[i].z * rb * g.z; o.w = vb[i].w * rb * g.w;
      *(float4*)(src + DM + n) = o;
    }
  }
}

enum { EPI_QKV = 0, EPI_RES = 1, EPI_GU = 2 };

struct EpiArgs {
  int layer;
  const float* res_lat;
  const float* res_ctx;
  int gate_chunk;
};

template <int EPI>
DI void epilogue(const Params& p, const EpiArgs& ea, const f32x16& acc, int n0, int b, int j, int hh) {
  const size_t m = (size_t)b * TOKB + j;
  if (EPI == EPI_QKV) {
    const int part = n0 >> 10, nn = n0 & 1023;
    if (part < 2) {
      float v[16];
#pragma unroll
      for (int i = 0; i < 16; ++i) v[i] = acc[i];
      if (ea.layer == 0 && j >= 256) {
        const int t = j - 256;
        const int pos = ((n0 & 32) == 0) ? (t >> 6) : (t & 63);
        const float2* tb = (const float2*)p.tab + pos * 16;
#pragma unroll
        for (int i = 0; i < 8; ++i) {
          const int f = (i & 3) + 8 * (i >> 2) + 4 * hh;
          float2 cs = tb[f];
          float a = v[i], bb = v[i + 8];
          v[i] = a * cs.x - bb * cs.y;
          v[i + 8] = bb * cs.x + a * cs.y;
        }
      }
      if (part == 0) {
#pragma unroll
        for (int i = 0; i < 16; ++i) v[i] *= 0.125f;
      }
      u16* dst = (part == 0 ? p.q : p.k) + m * DM + nn + 4 * hh;
#pragma unroll
      for (int g = 0; g < 4; ++g) {
        uint2 o; o.x = pk2(v[4 * g], v[4 * g + 1]); o.y = pk2(v[4 * g + 2], v[4 * g + 3]);
        *(uint2*)(dst + 8 * g) = o;
      }
    } else {
      u16* dst = p.vt + ((size_t)b * 1024 + nn + 4 * hh) * TOKB + j;
#pragma unroll
      for (int i = 0; i < 16; ++i) {
        const int rr = (i & 3) + 8 * (i >> 2);
        dst[(size_t)rr * TOKB] = (u16)(pk2(acc[i], 0.f) & 0xffffu);
      }
    }
  } else if (EPI == EPI_RES) {
    const bool isctx = j < 256;
    const size_t ro = isctx ? ((size_t)b * 256 + j) * DM : ((size_t)b * 2048 + (j - 256)) * DM;
    const float* src = (isctx ? ea.res_ctx : ea.res_lat) + ro;
    float* dst = (isctx ? p.hc : p.out) + ro;
    const float* gate = p.mod + ((size_t)ea.layer * 17 + (isctx ? 16 : b)) * 6144 + ea.gate_chunk * 1024;
#pragma unroll
    for (int g = 0; g < 4; ++g) {
      const int n = n0 + 8 * g + 4 * hh;
      float4 hv = *(const float4*)(src + n);
      float4 gt = *(const float4*)(gate + n);
      hv.x += gt.x * acc[4 * g]; hv.y += gt.y * acc[4 * g + 1]; hv.z += gt.z * acc[4 * g + 2]; hv.w += gt.w * acc[4 * g + 3];
      *(float4*)(dst + n) = hv;
    }
  } else {
    u16* dst = p.act + m * FF + (n0 >> 5) * 16 + 4 * hh;
#pragma unroll
    for (int g = 0; g < 2; ++g) {
      float a0 = silu_f(acc[4 * g]) * acc[4 * g + 8];
      float a1 = silu_f(acc[4 * g + 1]) * acc[4 * g + 9];
      float a2 = silu_f(acc[4 * g + 2]) * acc[4 * g + 10];
      float a3 = silu_f(acc[4 * g + 3]) * acc[4 * g + 11];
      uint2 o; o.x = pk2(a0, a1); o.y = pk2(a2, a3);
      *(uint2*)(dst + 8 * g) = o;
    }
  }
}

DI void stage_store_bf16(char* lw, int lane, const uint2 v0, const uint2 v1, const uint2 v2, const uint2 v3, const uint2 v4,
                         const uint2 v5, const uint2 v6, const uint2 v7, u16* gdst, size_t ld) {
  const int l31 = lane & 31, hh = lane >> 5;
  char* wp = lw + l31 * 136 + hh * 8;
  *(uint2*)(wp) = v0;       *(uint2*)(wp + 16) = v1;  *(uint2*)(wp + 32) = v2;  *(uint2*)(wp + 48) = v3;
  *(uint2*)(wp + 64) = v4;  *(uint2*)(wp + 80) = v5;  *(uint2*)(wp + 96) = v6;  *(uint2*)(wp + 112) = v7;
#pragma unroll
  for (int k = 0; k < 4; ++k) {
    const int c = lane + 64 * k;
    const int row = c >> 3, cc = c & 7;
    const uint2 lo = *(const uint2*)(lw + row * 136 + cc * 16);
    const uint2 hi = *(const uint2*)(lw + row * 136 + cc * 16 + 8);
    *(uint4*)(gdst + (size_t)row * ld + cc * 8) = make_uint4(lo.x, lo.y, hi.x, hi.y);
  }
}
DI void stage_res_f32(char* lw, int lane, const f32x16& acc, const float* gsrc, float* gdst, const float* gate) {
  const int l31 = lane & 31, hh = lane >> 5;
  char* wp = lw + l31 * 144 + hh * 16;
#pragma unroll
  for (int g = 0; g < 4; ++g) *(float4*)(wp + g * 32) = make_float4(acc[4 * g], acc[4 * g + 1], acc[4 * g + 2], acc[4 * g + 3]);
#pragma unroll
  for (int k = 0; k < 4; ++k) {
    const int c = lane + 64 * k;
    const int row = c >> 3, cc = c & 7;
    const float4 a = *(const float4*)(lw + row * 144 + cc * 16);
    const float4 gt = *(const float4*)(gate + cc * 4);
    float4 hv = *(const float4*)(gsrc + (size_t)row * DM + cc * 4);
    hv.x += gt.x * a.x; hv.y += gt.y * a.y; hv.z += gt.z * a.z; hv.w += gt.w * a.w;
    *(float4*)(gdst + (size_t)row * DM + cc * 4) = hv;
  }
}

typedef __attribute__((ext_vector_type(4))) unsigned u32x4;
struct Stage { u32x4 x0, x1, x2, x3, w0, w1, w2, w3; };

template <int EPI, int TN>
DI void phase_gemm(const int wv, const Params& p, const EpiArgs& ea, const u16* __restrict__ Wt, const u16* __restrict__ X, const int K, const int ntn,
                   const bool lat_only, char* smem) {
  constexpr int NT2 = TN / 64;
  constexpr int STG = (256 + TN) * 128;
  constexpr int WOFF = 32768;
  const int lane = lane_id_(), w = wv, tid = w * 64 + lane, l31 = lane & 31, hh = lane >> 5;
  const int wm = w & 3, wn = w >> 2;
  const int lc = tid & 7, lr = tid >> 3;
  const int nmt = lat_only ? 128 : 144;
  const int total = nmt * ntn;
  const int nk = K >> 6;
  if ((int)blockIdx.x >= total) return;
  const int my_tiles = (total - (int)blockIdx.x + (int)gridDim.x - 1) / (int)gridDim.x;
  const int nitems = my_tiles * nk;
  const unsigned st_off = lr * 128 + ((lc ^ ((lr >> 1) & 7)) << 4);
  const unsigned sw = (l31 >> 1) & 7;
  const unsigned xr_off = (wm * 64 + l31) * 128;
  const unsigned wr_off = WOFF + (wn * (TN / 2) + l31) * 128;
  char* const buf0 = smem;
  char* const buf1 = smem + STG;

  int lt = blockIdx.x, lko = 0;
  const u16 *xg, *wg;
#define SETP(t_)                                                            \
  {                                                                         \
    const int mi_ = (t_) / ntn, nt_ = (t_) - mi_ * ntn;                     \
    const int mt_ = lat_only ? (mi_ >> 3) * 9 + 1 + (mi_ & 7) : mi_;        \
    xg = X + (size_t)(mt_ * 256 + lr) * K + lc * 8;                         \
    wg = Wt + (size_t)(nt_ * TN + lr) * K + lc * 8;                         \
  }
#define LOADS(s_)                                                           \
  {                                                                         \
    s_.x0 = *(const u32x4*)(xg + lko);                                      \
    s_.x1 = *(const u32x4*)(xg + (size_t)64 * K + lko);                     \
    s_.x2 = *(const u32x4*)(xg + (size_t)128 * K + lko);                    \
    s_.x3 = *(const u32x4*)(xg + (size_t)192 * K + lko);                    \
    s_.w0 = *(const u32x4*)(wg + lko);                                      \
    s_.w1 = *(const u32x4*)(wg + (size_t)64 * K + lko);                     \
    if (TN > 128) {                                                         \
      s_.w2 = *(const u32x4*)(wg + (size_t)128 * K + lko);                  \
      s_.w3 = *(const u32x4*)(wg + (size_t)192 * K + lko);                  \
    }                                                                       \
    lko += 64;                                                              \
    if (lko == K) {                                                         \
      lko = 0;                                                              \
      if (lt + (int)gridDim.x < total) lt += gridDim.x;                     \
      SETP(lt);                                                             \
    }                                                                       \
  }
#define STORES(s_, sb_)                                                     \
  {                                                                         \
    *(u32x4*)((sb_) + st_off) = s_.x0;                                      \
    *(u32x4*)((sb_) + st_off + 8192) = s_.x1;                               \
    *(u32x4*)((sb_) + st_off + 16384) = s_.x2;                              \
    *(u32x4*)((sb_) + st_off + 24576) = s_.x3;                              \
    *(u32x4*)((sb_) + WOFF + st_off) = s_.w0;                               \
    *(u32x4*)((sb_) + WOFF + st_off + 8192) = s_.w1;                        \
    if (TN > 128) {                                                         \
      *(u32x4*)((sb_) + WOFF + st_off + 16384) = s_.w2;                     \
      *(u32x4*)((sb_) + WOFF + st_off + 24576) = s_.w3;                     \
    }                                                                       \
  }
#define RD(sb_, ks_, F_)                                                                        \
  {                                                                                             \
    const unsigned co_ = ((unsigned)((ks_) * 2 + hh) ^ sw) << 4;                                \
    F_.q0 = *(const bf16x8*)((sb_) + xr_off + co_);                                             \
    F_.q1 = *(const bf16x8*)((sb_) + xr_off + 4096 + co_);                                      \
    F_.p0 = *(const bf16x8*)((sb_) + wr_off + co_);                                             \
    F_.p1 = *(const bf16x8*)((sb_) + wr_off + 4096 + co_);                                      \
  }
#define MM(F_)                                                                                  \
  {                                                                                             \
    acc[0][0] = MFMA(F_.p0, F_.q0, acc[0][0]);                                                  \
    acc[0][1] = MFMA(F_.p0, F_.q1, acc[0][1]);                                                  \
    acc[1][0] = MFMA(F_.p1, F_.q0, acc[1][0]);                                                  \
    acc[1][1] = MFMA(F_.p1, F_.q1, acc[1][1]);                                                  \
  }
#define SB __builtin_amdgcn_sched_barrier(0)
#define ITEM(rb_, sset_, wb_)                                                                   \
  {                                                                                             \
    RD(rb_, 0, F0); RD(rb_, 1, F1); SB;                                                         \
    MM(F0); RD(rb_, 2, F2); SB;                                                                 \
    MM(F1); RD(rb_, 3, F3); SB;                                                                 \
    STORES(sset_, wb_); LOADS(sset_); SB;                                                       \
    MM(F2); SB;                                                                                 \
    MM(F3); SB;                                                                                 \
    __syncthreads();                                                                            \
    ++g;                                                                                        \
  }

  static_assert(TN == 128, "wave tile is 64x64");
  struct Frag { bf16x8 p0, p1, q0, q1; };
  Frag F0, F1, F2, F3;
  Stage sA, sB;
  sA.w2 = sA.w3 = sB.w2 = sB.w3 = (u32x4){0u, 0u, 0u, 0u};
  SETP(lt);
  LOADS(sA);
  LOADS(sB);
  __syncthreads();
  STORES(sA, buf0);
  LOADS(sA);
  __syncthreads();
  int g = 0;
  for (int ct = blockIdx.x; ct < total; ct += gridDim.x) {
    f32x16 acc[NT2][2];
#pragma unroll
    for (int a = 0; a < NT2; ++a)
#pragma unroll
      for (int bq = 0; bq < 2; ++bq)
#pragma unroll
        for (int i = 0; i < 16; ++i) acc[a][bq][i] = 0.f;
    for (int kt = 0; kt < nk; kt += 2) {
      ITEM(buf0, sB, buf1);
      ITEM(buf1, sA, buf0);
    }
    const int mi = ct / ntn, nt = ct - mi * ntn;
    const int mt = lat_only ? (mi >> 3) * 9 + 1 + (mi & 7) : mi;
    const int b = mt / 9;
    const int jb = (mt - b * 9) * 256 + wm * 64 + l31;
#pragma unroll
    for (int a = 0; a < NT2; ++a)
#pragma unroll
      for (int bq = 0; bq < 2; ++bq)
        epilogue<EPI>(p, ea, acc[a][bq], nt * TN + wn * (TN / 2) + a * 32, b, jb + bq * 32, hh);
  }
#undef SETP
#undef LOADS
#undef STORES
#undef RD
#undef MM
#undef ITEM
}

DI bool tile_of(int r, int nmt, int NN, int GM, int GN, int& mi, int& nt) {
  if (gridDim.x == 256) {
    const int x = blockIdx.x & 7, sl = blockIdx.x >> 3;
    const int NG = NN / GN;
    const int c = r * 8 + x;
    if (c >= (nmt / GM) * NG) return false;
    const int mg = c / NG, ng = c - mg * NG;
    const int sm = sl / GN;
    mi = mg * GM + sm;
    nt = ng * GN + (sl - sm * GN);
    return true;
  }
  const int t = r * gridDim.x + blockIdx.x;
  if (t >= nmt * NN) return false;
  mi = t / NN;
  nt = t - mi * NN;
  return true;
}

template <int EPI>
DI void phase_gemm256(const int wv, const Params& p, const EpiArgs& ea, const u16* __restrict__ Wt, const u16* __restrict__ X, const int K, const int NN,
                      const int GM, const int GN, const bool lat_only, char* smem, const int tail_lo = 0, const int tail_hi = 0,
                      const NormSpec ns = NormSpec{0, nullptr, 0, 0, 0}, int* cnt = nullptr) {
  constexpr int STG = 65536;
  constexpr int WOFF = 32768;
  const int lane = lane_id_(), w = wv, tid = w * 64 + lane, l31 = lane & 31, hh = lane >> 5;
  const int wm = w & 3, wn = w >> 2;
  const int lc = tid & 7, lr = tid >> 3;
  const int nmt = lat_only ? 128 : 144;
  const int nk = K >> 6;
  int nr = 0;
  {
    int a_, b_;
    while (tile_of(nr, nmt, NN, GM, GN, a_, b_)) ++nr;
  }
  int tw_rank = blockIdx.x, tw_cnt = gridDim.x;
  if (tail_hi > tail_lo && gridDim.x == 256) {
    const int nchunks = (nmt / GM) * (NN / GN);
    const int nrmax = (nchunks + 7) >> 3;
    int nidle = 0, before = 0;
    for (int x = 0; x < 8; ++x) {
      const int nrx = x < nchunks ? (nchunks - x + 7) >> 3 : 0;
      if (nrx < nrmax) { if (x < (int)(blockIdx.x & 7)) ++before; ++nidle; }
    }
    if (nidle > 0) {
      tw_cnt = nidle * 32;
      tw_rank = (nr < nrmax) ? before * 32 + (int)(blockIdx.x >> 3) : -1;
    }
  }
#define TAIL_WORK()                                                                   \
  if (tail_hi > tail_lo && tw_rank >= 0) {                                            \
    for (int tt_ = tail_lo + tw_rank; tt_ < tail_hi; tt_ += tw_cnt) conv_list_tile(wv, p, tt_, smem); \
  }
  if (nr == 0) { TAIL_WORK(); return; }
  const unsigned st_off = lr * 128 + ((lc ^ ((lr >> 1) & 7)) << 4);
  const unsigned sw = (l31 >> 1) & 7;
  const unsigned xr_off = (wm * 64 + l31) * 128;
  const unsigned wr_off = WOFF + (wn * 128 + l31) * 128;
  char* const buf0 = smem;
  char* const buf1 = smem + STG;

  int lrd = 0, lko = 0;
  const u16 *xg, *wg;
  const int gch = (lane & 7) ^ (((lane >> 4) + 4 * w) & 7);
  const unsigned lds_w = w * 1024;
#define SETP(r_)                                                            \
  {                                                                         \
    int mi_, nt_;                                                           \
    tile_of((r_), nmt, NN, GM, GN, mi_, nt_);                               \
    const int mt_ = lat_only ? (mi_ >> 3) * 9 + 1 + (mi_ & 7) : mi_;        \
    xg = X + (size_t)(mt_ * 256 + lr) * K + gch * 8;                        \
    wg = Wt + (size_t)(nt_ * 256 + lr) * K + gch * 8;                       \
  }
#define GL1(g_, l_) __builtin_amdgcn_global_load_lds((const unsigned*)(g_), (unsigned*)(l_), 16, 0, 0)
#define GLDS_X(sb_)                                                         \
  {                                                                         \
    GL1(xg + lko, (sb_) + lds_w);                                           \
    GL1(xg + (size_t)64 * K + lko, (sb_) + lds_w + 8192);                   \
    GL1(xg + (size_t)128 * K + lko, (sb_) + lds_w + 16384);                 \
    GL1(xg + (size_t)192 * K + lko, (sb_) + lds_w + 24576);                 \
  }
#define GLDS_W(sb_)                                                         \
  {                                                                         \
    GL1(wg + lko, (sb_) + WOFF + lds_w);                                    \
    GL1(wg + (size_t)64 * K + lko, (sb_) + WOFF + lds_w + 8192);            \
    GL1(wg + (size_t)128 * K + lko, (sb_) + WOFF + lds_w + 16384);          \
    GL1(wg + (size_t)192 * K + lko, (sb_) + WOFF + lds_w + 24576);          \
    lko += 64;                                                              \
    if (lko == K) {                                                         \
      lko = 0;                                                              \
      if (lrd + 1 < nr) ++lrd;                                              \
      SETP(lrd);                                                            \
    }                                                                       \
  }
#define GLDS(sb_) { GLDS_X(sb_); GLDS_W(sb_); }
#define WAITV0 asm volatile("s_waitcnt vmcnt(0)" ::: "memory")
#define RD(sb_, ks_, F_)                                                                        \
  {                                                                                             \
    const unsigned co_ = ((unsigned)((ks_) * 2 + hh) ^ sw) << 4;                                \
    F_.q0 = *(const bf16x8*)((sb_) + xr_off + co_);                                             \
    F_.q1 = *(const bf16x8*)((sb_) + xr_off + 4096 + co_);                                      \
    F_.p0 = *(const bf16x8*)((sb_) + wr_off + co_);                                             \
    F_.p1 = *(const bf16x8*)((sb_) + wr_off + 4096 + co_);                                      \
    F_.p2 = *(const bf16x8*)((sb_) + wr_off + 8192 + co_);                                      \
    F_.p3 = *(const bf16x8*)((sb_) + wr_off + 12288 + co_);                                     \
  }
#define MM1(F_)                                                                                 \
  {                                                                                             \
    acc[0][0] = MFMA(F_.p0, F_.q0, acc[0][0]);                                                  \
  }
#define MM7(F_)                                                                                 \
  {                                                                                             \
    acc[0][1] = MFMA(F_.p0, F_.q1, acc[0][1]);                                                  \
    acc[1][0] = MFMA(F_.p1, F_.q0, acc[1][0]);                                                  \
    acc[1][1] = MFMA(F_.p1, F_.q1, acc[1][1]);                                                  \
    acc[2][0] = MFMA(F_.p2, F_.q0, acc[2][0]);                                                  \
    acc[2][1] = MFMA(F_.p2, F_.q1, acc[2][1]);                                                  \
    acc[3][0] = MFMA(F_.p3, F_.q0, acc[3][0]);                                                  \
    acc[3][1] = MFMA(F_.p3, F_.q1, acc[3][1]);                                                  \
  }
#define ITEM(rb_, wb_)                                                                          \
  {                                                                                             \
    if (early) GLDS_X(wb_);                                                                     \
    MM1(FA); SB;                                                                                \
    if (early) GLDS_W(wb_);                                                                     \
    RD(rb_, 1, FB); SB; MM7(FA); SB;                                                            \
    if (!early) GLDS_X(wb_);                                                                    \
    MM1(FB); SB;                                                                                \
    if (!early) GLDS_W(wb_);                                                                    \
    RD(rb_, 2, FA); SB; MM7(FB); SB;                                                            \
    MM1(FA); SB; RD(rb_, 3, FB); SB; MM7(FA); SB;                                               \
    WAITV0;                                                                                     \
    __syncthreads();                                                                            \
    MM1(FB); SB; RD(wb_, 0, FA); SB; MM7(FB); SB;                                               \
  }

  struct Frag6 { bf16x8 p0, p1, p2, p3, q0, q1; };
  Frag6 FA, FB;
  const bool early = w < 4;
  SETP(0);
  __syncthreads();
  GLDS(buf0);
  WAITV0;
  __syncthreads();
  RD(buf0, 0, FA);
  for (int r = 0; r < nr; ++r) {
    f32x16 acc[4][2];
#pragma unroll
    for (int a = 0; a < 4; ++a)
#pragma unroll
      for (int bq = 0; bq < 2; ++bq)
#pragma unroll
        for (int i = 0; i < 16; ++i) acc[a][bq][i] = 0.f;
    for (int kt = 0; kt < nk; kt += 2) {
      ITEM(buf0, buf1);
      ITEM(buf1, buf0);
    }
    int mi, nt;
    tile_of(r, nmt, NN, GM, GN, mi, nt);
    const int mt = lat_only ? (mi >> 3) * 9 + 1 + (mi & 7) : mi;
    const int b = mt / 9;
    const int jb = (mt - b * 9) * 256 + wm * 64 + l31;
    char* const lw = buf1 + w * 8192;
    const int jw = (mt - b * 9) * 256 + wm * 64;
    const int nw = nt * 256 + wn * 128;
    if (EPI == EPI_QKV && nw >= 2048) {
#pragma unroll
      for (int a = 0; a < 4; ++a)
#pragma unroll
        for (int bq = 0; bq < 2; ++bq)
          epilogue<EPI>(p, ea, acc[a][bq], nw + a * 32, b, jb + bq * 32, hh);
    } else if (EPI == EPI_QKV) {
      const int part = nw >> 10, nn = nw & 1023;
      const bool rope = (ea.layer == 0) && (jw >= 256);
      const float qs = part == 0 ? 0.125f : 1.f;
      u16* const dbase = (part == 0 ? p.q : p.k) + ((size_t)b * TOKB + jw) * DM + nn;
#pragma unroll
      for (int bq = 0; bq < 2; ++bq) {
        const int t = jw + bq * 32 + l31 - 256;
#pragma unroll
        for (int hf = 0; hf < 2; ++hf) {
          uint2 pk[8];
#pragma unroll
          for (int a2 = 0; a2 < 2; ++a2) {
            const int a = hf * 2 + a2;
            __builtin_amdgcn_sched_barrier(0);
            float v[16];
#pragma unroll
            for (int i = 0; i < 16; ++i) v[i] = acc[a][bq][i];
            if (rope) {
              const int pos = (a2 == 0) ? (t >> 6) : (t & 63);
              const float2* tb = (const float2*)p.tab + pos * 16;
#pragma unroll
              for (int i = 0; i < 8; ++i) {
                const int f = (i & 3) + 8 * (i >> 2) + 4 * hh;
                const float2 cs = tb[f];
                const float x0 = v[i], x1 = v[i + 8];
                v[i] = x0 * cs.x - x1 * cs.y;
                v[i + 8] = x1 * cs.x + x0 * cs.y;
              }
            }
#pragma unroll
            for (int g = 0; g < 4; ++g) {
              pk[a2 * 4 + g].x = pk2(v[4 * g] * qs, v[4 * g + 1] * qs);
              pk[a2 * 4 + g].y = pk2(v[4 * g + 2] * qs, v[4 * g + 3] * qs);
            }
          }
          stage_store_bf16(lw, lane, pk[0], pk[1], pk[2], pk[3], pk[4], pk[5], pk[6], pk[7],
                           dbase + (size_t)(bq * 32) * DM + hf * 64, DM);
        }
      }
    } else if (EPI == EPI_GU) {
      u16* const dbase = p.act + ((size_t)b * TOKB + jw) * FF + (nw >> 1);
#pragma unroll
      for (int bq = 0; bq < 2; ++bq) {
        uint2 pk[8];
#pragma unroll
        for (int a = 0; a < 4; ++a)
#pragma unroll
          for (int g = 0; g < 2; ++g) {
            const float a0 = silu_f(acc[a][bq][4 * g]) * acc[a][bq][4 * g + 8];
            const float a1 = silu_f(acc[a][bq][4 * g + 1]) * acc[a][bq][4 * g + 9];
            const float a2 = silu_f(acc[a][bq][4 * g + 2]) * acc[a][bq][4 * g + 10];
            const float a3 = silu_f(acc[a][bq][4 * g + 3]) * acc[a][bq][4 * g + 11];
            pk[a * 2 + g].x = pk2(a0, a1);
            pk[a * 2 + g].y = pk2(a2, a3);
          }
        stage_store_bf16(lw, lane, pk[0], pk[1], pk[2], pk[3], pk[4], pk[5], pk[6], pk[7], dbase + (size_t)(bq * 32) * FF, FF);
      }
    } else {
      const bool isctx = jw < 256;
      const size_t ro = isctx ? ((size_t)b * 256 + jw) * DM : ((size_t)b * 2048 + (jw - 256)) * DM;
      const float* const sbase = (isctx ? ea.res_ctx : ea.res_lat) + ro + nw;
      float* const dbase = (isctx ? p.hc : p.out) + ro + nw;
      const float* const gate = p.mod + ((size_t)ea.layer * 17 + (isctx ? 16 : b)) * 6144 + ea.gate_chunk * 1024 + nw;
#pragma unroll
      for (int a = 0; a < 4; ++a)
#pragma unroll
        for (int bq = 0; bq < 2; ++bq)
          stage_res_f32(lw, lane, acc[a][bq], sbase + (size_t)(bq * 32) * DM + a * 32, dbase + (size_t)(bq * 32) * DM + a * 32,
                        gate + a * 32);
    }
    __syncthreads();
    if (EPI == EPI_RES && ns.kind != 0 && gridDim.x == 256) {
      const int c = r * 8 + (int)(blockIdx.x & 7);
      __builtin_amdgcn_fence(__ATOMIC_RELEASE, "agent");
      __syncthreads();
      if (tid == 0) {
        __hip_atomic_fetch_add(cnt + c, 1, __ATOMIC_RELAXED, __HIP_MEMORY_SCOPE_AGENT);
        while (__hip_atomic_load(cnt + c, __ATOMIC_RELAXED, __HIP_MEMORY_SCOPE_AGENT) < 32) __builtin_amdgcn_s_sleep(4);
      }
      __syncthreads();
      __builtin_amdgcn_fence(__ATOMIC_ACQUIRE, "agent");
      const int sl = (int)(blockIdx.x >> 3);
#pragma unroll 2
      for (int q = 0; q < 8; ++q) {
        const int rr = sl * 64 + w * 8 + q;
        const int mi2 = c * 8 + (rr >> 8);
        const int mt2 = lat_only ? (mi2 >> 3) * 9 + 1 + (mi2 & 7) : mi2;
        norm_one_row(p, ns, mt2 * 256 + (rr & 255), lane);
      }
    }
    RD(buf0, 0, FA);
  }
#undef SETP
  __syncthreads();
  TAIL_WORK();
#undef TAIL_WORK
#undef GLDS
#undef GLDS_X
#undef GLDS_W
#undef GL1
#undef RD
#undef MM1
#undef MM7
#undef ITEM
}

DI float halfmax(float x) {
  const unsigned u = __builtin_bit_cast(unsigned, x);
  const auto r = __builtin_amdgcn_permlane32_swap(u, u, false, false);
  return fmaxf(__builtin_bit_cast(float, (unsigned)r[0]), __builtin_bit_cast(float, (unsigned)r[1]));
}
DI float halfsum(float x) {
  const unsigned u = __builtin_bit_cast(unsigned, x);
  const auto r = __builtin_amdgcn_permlane32_swap(u, u, false, false);
  return __builtin_bit_cast(float, (unsigned)r[0]) + __builtin_bit_cast(float, (unsigned)r[1]);
}

struct VFrag4 { bf16x8 f0, f1, f2, f3; };
template <int ND>
DI void rd_vgroup(const char* vp, VFrag4& V) {
#define RDV1(d_, dst_)                                                     \
  {                                                                        \
    dst_ = *(const bf16x8*)(vp + (d_) * 32 * 144);                         \
  }
  RDV1(0, V.f0) RDV1(1, V.f1)
  if (ND > 2) { RDV1(2, V.f2) RDV1(3, V.f3) }
#undef RDV1
}
#define PV_GRP(ND_, V_, P_)                          \
  {                                                  \
    O[0] = MFMA(V_.f0, P_, O[0]);                    \
    O[1] = MFMA(V_.f1, P_, O[1]);                    \
    if (ND_ > 2) {                                   \
      O[2 % ND_] = MFMA(V_.f2, P_, O[2 % ND_]);      \
      O[3 % ND_] = MFMA(V_.f3, P_, O[3 % ND_]);      \
    }                                                \
  }
#define PV_ALL(ND_)                                                            \
  {                                                                            \
    VFrag4 vA, vB;                                                             \
    const char* vbase = sb + vfo;                                              \
    __builtin_amdgcn_sched_barrier(0);                                         \
    rd_vgroup<ND_>(vbase, vA);                                                 \
    rd_vgroup<ND_>(vbase + 32, vB);                                            \
    __builtin_amdgcn_sched_barrier(0);                                         \
    PV_GRP(ND_, vA, pf[0][0]);                                                 \
    __builtin_amdgcn_sched_barrier(0);                                         \
    rd_vgroup<ND_>(vbase + 64, vA);                                            \
    __builtin_amdgcn_sched_barrier(0);                                         \
    PV_GRP(ND_, vB, pf[0][1]);                                                 \
    __builtin_amdgcn_sched_barrier(0);                                         \
    rd_vgroup<ND_>(vbase + 96, vB);                                            \
    __builtin_amdgcn_sched_barrier(0);                                         \
    PV_GRP(ND_, vA, pf[1][0]);                                                 \
    __builtin_amdgcn_sched_barrier(0);                                         \
    PV_GRP(ND_, vB, pf[1][1]);                                                 \
    __builtin_amdgcn_sched_barrier(0);                                         \
  }

template <int NA>
DI void attn_item(const int wv, const Params& p, int b, int hsel, int qj0, int nsteps, int qrow, char* smem) {
  constexpr int KWB = NA ? 512 : 256;
  constexpr int VR = NA ? 256 : 128;
  constexpr int KSZ = 64 * KWB;
  constexpr int BUFSZ = KSZ + VR * 144;
  constexpr int NL = NA ? 4 : 2;
  constexpr int DT = NA ? 2 : 4;
  const int lane = lane_id_(), w = wv, tid = w * 64 + lane, l31 = lane & 31, hh = lane >> 5;
  const int sub = w >> 1;
  const int par = w & 1;
  const int qg = NA ? par : sub;
  const int j = qj0 + qg * 32 + l31;
  const int qcol = NA ? (hsel * 4 + sub) * 64 : hsel * 128 + par * 64;
  const int cb = NA ? sub * 8 : par * 8;
  const int vb = NA ? sub * 64 : 0;
  const int kcol0 = NA ? hsel * 256 : hsel * 128;
  const int vrow0 = kcol0;
  int rs = 0;
  if (NA) { rs = qrow - 4; rs = rs < 0 ? 0 : (rs > 24 ? 24 : rs); }

  bf16x8 qf[4];
  {
    const u16* qp = p.q + ((size_t)b * TOKB + j) * DM + qcol + hh * 8;
#pragma unroll
    for (int ks = 0; ks < 4; ++ks) qf[ks] = *(const bf16x8*)(qp + ks * 16);
  }
  const int kc = NA ? (tid & 31) : (tid & 15);
  const int kr = NA ? (tid >> 5) : (tid >> 4);
  constexpr int KRS = NA ? 16 : 32;
  const u16* kg = p.k + ((size_t)b * TOKB + kr) * DM + kcol0 + kc * 8;
  const unsigned kst = kr * KWB + ((kc ^ (kr & 15)) << 4);
  const int vc = tid & 7, vr = tid >> 3;
  const u16* vg = p.vt + ((size_t)b * 1024 + vrow0 + vr) * TOKB + vc * 8;
  const unsigned vst = KSZ + vr * 144 + (vc >> 1) * 32 + (vc & 1) * 8;
  uint4 rk0, rk1, rk2, rk3, rv0, rv1, rv2, rv3;
  rk2 = rk3 = rv2 = rv3 = make_uint4(0, 0, 0, 0);
#define GLOAD(t_)                                                                         \
  {                                                                                       \
    const int tt_ = (t_);                                                                 \
    const int key0 = NA ? (tt_ < 4 ? tt_ * 64 : 256 + (rs + tt_ - 4) * 64) : tt_ * 64;    \
    rk0 = *(const uint4*)(kg + (size_t)(key0) * DM);                                      \
    rk1 = *(const uint4*)(kg + (size_t)(key0 + KRS) * DM);                                \
    if (NL > 2) {                                                                         \
      rk2 = *(const uint4*)(kg + (size_t)(key0 + 2 * KRS) * DM);                          \
      rk3 = *(const uint4*)(kg + (size_t)(key0 + 3 * KRS) * DM);                          \
    }                                                                                     \
    rv0 = *(const uint4*)(vg + key0);                                                     \
    rv1 = *(const uint4*)(vg + (size_t)64 * TOKB + key0);                                 \
    if (NL > 2) {                                                                         \
      rv2 = *(const uint4*)(vg + (size_t)128 * TOKB + key0);                              \
      rv3 = *(const uint4*)(vg + (size_t)192 * TOKB + key0);                              \
    }                                                                                     \
  }

  f32x16 O[DT];
#pragma unroll
  for (int d = 0; d < DT; ++d)
#pragma unroll
    for (int i = 0; i < 16; ++i) O[d][i] = 0.f;
  float m_run = -INFINITY, l_run = 0.f;

  const unsigned kfo = l31 * KWB;
  const unsigned ksw = l31 & 15;
  const unsigned vfo = KSZ + (vb + l31) * 144 + hh * 16;
  const int qc = qg * 32 + l31;
  int cs0 = qc - 8; cs0 = cs0 < 0 ? 0 : (cs0 > 48 ? 48 : cs0);

  GLOAD(0);
  __syncthreads();
  if (NA) {
    float* rl = (float*)(smem + RPB_OFF);
    const float* rg = p.rpb + (size_t)hsel * 4 * 15 * 31;
    for (int e = tid; e < 4 * 15 * 31; e += 512) rl[e] = rg[e];
  }
  for (int t = 0; t < nsteps; ++t) {
    char* sb = smem + (t & 1) * BUFSZ;
    *(uint4*)(sb + kst) = rk0;
    *(uint4*)(sb + kst + KRS * KWB) = rk1;
    if (NL > 2) {
      *(uint4*)(sb + kst + 2 * KRS * KWB) = rk2;
      *(uint4*)(sb + kst + 3 * KRS * KWB) = rk3;
    }
#define VSTORE(i_, r_)                                                        \
    *(uint2*)(sb + vst + (i_) * 64 * 144) = make_uint2((r_).x, (r_).y);       \
    *(uint2*)(sb + vst + (i_) * 64 * 144 + 16) = make_uint2((r_).z, (r_).w);
    VSTORE(0, rv0)
    VSTORE(1, rv1)
    if (NL > 2) {
      VSTORE(2, rv2)
      VSTORE(3, rv3)
    }
    __syncthreads();
    if (t + 1 < nsteps) GLOAD(t + 1);

    f32x16 S[2];
#pragma unroll
    for (int kt = 0; kt < 2; ++kt)
#pragma unroll
      for (int i = 0; i < 16; ++i) S[kt][i] = 0.f;
    {
      bf16x8 kf[2][4];
#pragma unroll
      for (int ks = 0; ks < 4; ++ks)
#pragma unroll
        for (int kt = 0; kt < 2; ++kt)
          kf[kt][ks] = *(const bf16x8*)(sb + kfo + kt * 32 * KWB + (((unsigned)(cb + ks * 2 + hh) ^ ksw) << 4));
      __builtin_amdgcn_sched_barrier(0);
#pragma unroll
      for (int ks = 0; ks < 4; ++ks)
#pragma unroll
        for (int kt = 0; kt < 2; ++kt) S[kt] = MFMA(kf[kt][ks], qf[ks], S[kt]);
      __builtin_amdgcn_sched_barrier(0);
    }
    if (NA) {
      if (t >= 4) {
        const int dr = rs + (t - 4) - qrow + 7;
        const float* bl = (const float*)(smem + RPB_OFF) + (sub * 15 + dr) * 31 + 4 * hh - qc + 15;
        const int d0 = 4 * hh - cs0;
#pragma unroll
        for (int kt = 0; kt < 2; ++kt)
#pragma unroll
          for (int i = 0; i < 16; ++i) {
            const int ci = kt * 32 + (i & 3) + 8 * (i >> 2);
            const bool valid = (unsigned)(d0 + ci) < 16u;
            const float bv = bl[ci];
            S[kt][i] = valid ? S[kt][i] + bv : -INFINITY;
          }
      }
    }
    float mx = S[0][0];
#pragma unroll
    for (int i = 1; i < 16; ++i) mx = fmaxf(mx, S[0][i]);
#pragma unroll
    for (int i = 0; i < 16; ++i) mx = fmaxf(mx, S[1][i]);
    mx = halfmax(mx);
    const bool need = mx > m_run + 5.5f;
    if (__builtin_amdgcn_ballot_w64(need) != 0ull) {
      const float mn = need ? mx : m_run;
      const float alpha = __builtin_amdgcn_exp2f((m_run - mn) * L2E);
      m_run = mn;
      l_run *= alpha;
#pragma unroll
      for (int d = 0; d < DT; ++d)
#pragma unroll
        for (int i = 0; i < 16; ++i) O[d][i] *= alpha;
    }
    const float mL = m_run * L2E;
    float psum = 0.f;
#pragma unroll
    for (int kt = 0; kt < 2; ++kt)
#pragma unroll
      for (int i = 0; i < 16; ++i) {
        float pv = __builtin_amdgcn_exp2f(fmaf(S[kt][i], L2E, -mL));
        S[kt][i] = pv;
        psum += pv;
      }
    l_run += psum;
    bf16x8 pf[2][2];
#pragma unroll
    for (int kt = 0; kt < 2; ++kt)
#pragma unroll
      for (int s = 0; s < 2; ++s) {
        uint4 u;
        u.x = pk2(S[kt][8 * s], S[kt][8 * s + 1]);
        u.y = pk2(S[kt][8 * s + 2], S[kt][8 * s + 3]);
        u.z = pk2(S[kt][8 * s + 4], S[kt][8 * s + 5]);
        u.w = pk2(S[kt][8 * s + 6], S[kt][8 * s + 7]);
        pf[kt][s] = __builtin_bit_cast(bf16x8, u);
      }
    PV_ALL(DT);
  }

  const float lt = halfsum(l_run);
  const float inv = 1.f / lt;
  if (NA) {
    u16* dst = p.xn + ((size_t)b * TOKB + j) * DM + qcol + 4 * hh;
#pragma unroll
    for (int d = 0; d < DT; ++d)
#pragma unroll
      for (int g = 0; g < 4; ++g) {
        uint2 o;
        o.x = pk2(O[d][4 * g] * inv, O[d][4 * g + 1] * inv);
        o.y = pk2(O[d][4 * g + 2] * inv, O[d][4 * g + 3] * inv);
        *(uint2*)(dst + d * 32 + 8 * g) = o;
      }
    __syncthreads();
  } else {
    float* comb = (float*)smem;
    __syncthreads();
    if (par == 1) {
      const float sc = inv * p.lam[0];
#pragma unroll
      for (int d = 0; d < DT; ++d)
#pragma unroll
        for (int i = 0; i < 16; ++i) comb[(sub * 64 + d * 16 + i) * 64 + lane] = O[d][i] * sc;
    }
    __syncthreads();
    if (par == 0) {
      float ss = 0.f;
#pragma unroll
      for (int d = 0; d < DT; ++d)
#pragma unroll
        for (int i = 0; i < 16; ++i) {
          float v = O[d][i] * inv - comb[(sub * 64 + d * 16 + i) * 64 + lane];
          O[d][i] = v;
          ss += v * v;
        }
      ss = halfsum(ss);
      const float rr = rsqrtf(ss * (1.f / 128.f) + 1e-6f) * 0.8f;
      u16* dst = p.xn + ((size_t)b * TOKB + j) * DM + hsel * 128 + 4 * hh;
#pragma unroll
      for (int d = 0; d < DT; ++d)
#pragma unroll
        for (int g = 0; g < 4; ++g) {
          float4 sg = *(const float4*)(p.subln + d * 32 + 8 * g + 4 * hh);
          uint2 o;
          o.x = pk2(O[d][4 * g] * rr * sg.x, O[d][4 * g + 1] * rr * sg.y);
          o.y = pk2(O[d][4 * g + 2] * rr * sg.z, O[d][4 * g + 3] * rr * sg.w);
          *(uint2*)(dst + d * 32 + 8 * g) = o;
        }
    }
    __syncthreads();
  }
}

DI void na_item(const int wv, const Params& p, int b, int head, int r4, char* smem) {
  constexpr int KSZ = 64 * 128;
  constexpr int BUFSZ = KSZ + 64 * 136;
  const int lane = lane_id_(), w = wv, tid = w * 64 + lane, l31 = lane & 31, hh = lane >> 5;
  const int rp = w >> 2, cg = w & 3;
  const int r0 = r4 * 4;
  const int ra = r0 + 2 * rp;
  const int r_q = ra + (l31 >> 4);
  const int qc = cg * 16 + (l31 & 15);
  const int j = 256 + r_q * 64 + qc;
  const int qcol = head * 64;
  int rs_q = r_q - 4; rs_q = rs_q < 0 ? 0 : (rs_q > 24 ? 24 : rs_q);
  int rs_a = ra - 4; rs_a = rs_a < 0 ? 0 : (rs_a > 24 ? 24 : rs_a);
  int rs_b = ra - 3; rs_b = rs_b < 0 ? 0 : (rs_b > 24 ? 24 : rs_b);
  int rs_lo = r0 - 4; rs_lo = rs_lo < 0 ? 0 : (rs_lo > 24 ? 24 : rs_lo);
  int rs_hi = r0 - 1; rs_hi = rs_hi < 0 ? 0 : (rs_hi > 24 ? 24 : rs_hi);
  const int nsteps = 4 + rs_hi + 8 - rs_lo;
  int cs0 = qc - 8; cs0 = cs0 < 0 ? 0 : (cs0 > 48 ? 48 : cs0);
  int cw0 = cg * 16 - 8; cw0 = cw0 < 0 ? 0 : (cw0 > 32 ? 32 : cw0);
  bf16x8 qf[4];
  {
    const u16* qp = p.q + ((size_t)b * TOKB + j) * DM + qcol + hh * 8;
#pragma unroll
    for (int ks = 0; ks < 4; ++ks) qf[ks] = *(const bf16x8*)(qp + ks * 16);
  }
  const int kc = tid & 7, kr = tid >> 3;
  const u16* kg = p.k + ((size_t)b * TOKB + kr) * DM + qcol + kc * 8;
  const unsigned kst = kr * 128 + ((kc ^ ((kr >> 1) & 7)) << 4);
  const u16* vg = p.vt + ((size_t)b * 1024 + qcol + kr) * TOKB + kc * 8;
  const unsigned vst = KSZ + kr * 136 + kc * 16;
  uint4 rk, rv;
#define NGLOAD(t_)                                                              \
  {                                                                             \
    const int tt_ = (t_);                                                       \
    const int key0 = tt_ < 4 ? tt_ * 64 : 256 + (rs_lo + tt_ - 4) * 64;         \
    rk = *(const uint4*)(kg + (size_t)key0 * DM);                               \
    rv = *(const uint4*)(vg + key0);                                            \
  }
  f32x16 O[2];
#pragma unroll
  for (int d = 0; d < 2; ++d)
#pragma unroll
    for (int i = 0; i < 16; ++i) O[d][i] = 0.f;
  float m_run = -INFINITY, l_run = 0.f;
  const unsigned kfo = l31 * 128;
  const unsigned ksw = (l31 >> 1) & 7;
  const unsigned kfo_b = (cw0 + l31) * 128;
  const unsigned ksw_b = ((cw0 + l31) >> 1) & 7;
  const unsigned vfo = KSZ + l31 * 136 + hh * 8;
#define VFRAG(dst_, off_)                                                            \
  {                                                                                  \
    const uint2 lo_ = *(const uint2*)(sb + vfo + (off_));                            \
    const uint2 hi_ = *(const uint2*)(sb + vfo + (off_) + 16);                       \
    dst_ = __builtin_bit_cast(bf16x8, make_uint4(lo_.x, lo_.y, hi_.x, hi_.y));       \
  }
#define SOFTMAX_UPDATE(mx_)                                                          \
  {                                                                                  \
    float mxx_ = halfmax(mx_);                                                       \
    const bool need_ = mxx_ > m_run + 5.5f;                                          \
    if (__builtin_amdgcn_ballot_w64(need_) != 0ull) {                                \
      const float mn_ = need_ ? mxx_ : m_run;                                        \
      const float alpha_ = __builtin_amdgcn_exp2f((m_run - mn_) * L2E);              \
      m_run = mn_;                                                                   \
      l_run *= alpha_;                                                               \
      _Pragma("unroll") for (int d = 0; d < 2; ++d)                                  \
        _Pragma("unroll") for (int i = 0; i < 16; ++i) O[d][i] *= alpha_;            \
    }                                                                                \
  }
#define PACK8(dst_, S_, o_)                                                          \
  {                                                                                  \
    uint4 u_;                                                                        \
    u_.x = pk2(S_[(o_)], S_[(o_) + 1]);     u_.y = pk2(S_[(o_) + 2], S_[(o_) + 3]);  \
    u_.z = pk2(S_[(o_) + 4], S_[(o_) + 5]); u_.w = pk2(S_[(o_) + 6], S_[(o_) + 7]);  \
    dst_ = __builtin_bit_cast(bf16x8, u_);                                           \
  }

  NGLOAD(0);
  __syncthreads();
  {
    float* rl = (float*)(smem + RPB_OFF);
    const float* rg = p.rpb + (size_t)head * 15 * 31;
    for (int e = tid; e < 15 * 31; e += 512) rl[e] = rg[e];
  }
  for (int t = 0; t < nsteps; ++t) {
    char* sb = smem + (t & 1) * BUFSZ;
    *(uint4*)(sb + kst) = rk;
    *(uint2*)(sb + vst) = make_uint2(rv.x, rv.y);
    *(uint2*)(sb + vst + 8) = make_uint2(rv.z, rv.w);
    __syncthreads();
    if (t + 1 < nsteps) NGLOAD(t + 1);
    if (t < 4) {
      f32x16 S[2];
#pragma unroll
      for (int kt = 0; kt < 2; ++kt)
#pragma unroll
        for (int i = 0; i < 16; ++i) S[kt][i] = 0.f;
      {
        bf16x8 kf[2][4];
#pragma unroll
        for (int ks = 0; ks < 4; ++ks)
#pragma unroll
          for (int kt = 0; kt < 2; ++kt)
            kf[kt][ks] = *(const bf16x8*)(sb + kfo + kt * 32 * 128 + (((unsigned)(ks * 2 + hh) ^ ksw) << 4));
        __builtin_amdgcn_sched_barrier(0);
#pragma unroll
        for (int ks = 0; ks < 4; ++ks)
#pragma unroll
          for (int kt = 0; kt < 2; ++kt) S[kt] = MFMA(kf[kt][ks], qf[ks], S[kt]);
        __builtin_amdgcn_sched_barrier(0);
      }
      float mx = S[0][0];
#pragma unroll
      for (int i = 1; i < 16; ++i) mx = fmaxf(mx, S[0][i]);
#pragma unroll
      for (int i = 0; i < 16; ++i) mx = fmaxf(mx, S[1][i]);
      SOFTMAX_UPDATE(mx);
      const float mL = m_run * L2E;
      float psum = 0.f;
#pragma unroll
      for (int kt = 0; kt < 2; ++kt)
#pragma unroll
        for (int i = 0; i < 16; ++i) {
          const float pv = __builtin_amdgcn_exp2f(fmaf(S[kt][i], L2E, -mL));
          S[kt][i] = pv;
          psum += pv;
        }
      l_run += psum;
      bf16x8 p00, p01, p10, p11;
      PACK8(p00, S[0], 0); PACK8(p01, S[0], 8); PACK8(p10, S[1], 0); PACK8(p11, S[1], 8);
      bf16x8 va0, va1, vb0, vb1;
      __builtin_amdgcn_sched_barrier(0);
      VFRAG(va0, 0); VFRAG(va1, 32 * 136); VFRAG(vb0, 32); VFRAG(vb1, 32 * 136 + 32);
      __builtin_amdgcn_sched_barrier(0);
      O[0] = MFMA(va0, p00, O[0]); O[1] = MFMA(va1, p00, O[1]);
      __builtin_amdgcn_sched_barrier(0);
      VFRAG(va0, 64); VFRAG(va1, 32 * 136 + 64);
      __builtin_amdgcn_sched_barrier(0);
      O[0] = MFMA(vb0, p01, O[0]); O[1] = MFMA(vb1, p01, O[1]);
      __builtin_amdgcn_sched_barrier(0);
      VFRAG(vb0, 96); VFRAG(vb1, 32 * 136 + 96);
      __builtin_amdgcn_sched_barrier(0);
      O[0] = MFMA(va0, p10, O[0]); O[1] = MFMA(va1, p10, O[1]);
      O[0] = MFMA(vb0, p11, O[0]); O[1] = MFMA(vb1, p11, O[1]);
      __builtin_amdgcn_sched_barrier(0);
    } else {
      const int krow = rs_lo + t - 4;
      if (krow >= rs_a && krow < rs_b + 8) {
        f32x16 S1;
#pragma unroll
        for (int i = 0; i < 16; ++i) S1[i] = 0.f;
        {
          bf16x8 kf[4];
#pragma unroll
          for (int ks = 0; ks < 4; ++ks)
            kf[ks] = *(const bf16x8*)(sb + kfo_b + (((unsigned)(ks * 2 + hh) ^ ksw_b) << 4));
          __builtin_amdgcn_sched_barrier(0);
#pragma unroll
          for (int ks = 0; ks < 4; ++ks) S1 = MFMA(kf[ks], qf[ks], S1);
          __builtin_amdgcn_sched_barrier(0);
        }
        const bool rowok = (krow >= rs_q) && (krow < rs_q + 8);
        const float* bl = (const float*)(smem + RPB_OFF) + (krow - r_q + 7) * 31 + cw0 + 4 * hh - qc + 15;
        const int d0 = rowok ? (cw0 + 4 * hh - cs0) : 1000;
        float mx = -INFINITY;
#pragma unroll
        for (int i = 0; i < 16; ++i) {
          const int ci = (i & 3) + 8 * (i >> 2);
          const bool valid = (unsigned)(d0 + ci) < 16u;
          const float bv = bl[ci];
          const float sv = valid ? S1[i] + bv : -INFINITY;
          S1[i] = sv;
          mx = fmaxf(mx, sv);
        }
        SOFTMAX_UPDATE(mx);
        const float mL = m_run * L2E;
        float psum = 0.f;
#pragma unroll
        for (int i = 0; i < 16; ++i) {
          const float pv = __builtin_amdgcn_exp2f(fmaf(S1[i], L2E, -mL));
          S1[i] = pv;
          psum += pv;
        }
        l_run += psum;
        bf16x8 p0, p1;
        PACK8(p0, S1, 0); PACK8(p1, S1, 8);
        bf16x8 va0, va1, vb0, vb1;
        const int vo = cw0 * 2;
        __builtin_amdgcn_sched_barrier(0);
        VFRAG(va0, vo); VFRAG(va1, 32 * 136 + vo); VFRAG(vb0, vo + 32); VFRAG(vb1, 32 * 136 + vo + 32);
        __builtin_amdgcn_sched_barrier(0);
        O[0] = MFMA(va0, p0, O[0]); O[1] = MFMA(va1, p0, O[1]);
        O[0] = MFMA(vb0, p1, O[0]); O[1] = MFMA(vb1, p1, O[1]);
        __builtin_amdgcn_sched_barrier(0);
      }
    }
  }
  const float lt = halfsum(l_run);
  const float inv = 1.f / lt;
  u16* dst = p.xn + ((size_t)b * TOKB + j) * DM + qcol + 4 * hh;
#pragma unroll
  for (int d = 0; d < 2; ++d)
#pragma unroll
    for (int g = 0; g < 4; ++g) {
      uint2 o;
      o.x = pk2(O[d][4 * g] * inv, O[d][4 * g + 1] * inv);
      o.y = pk2(O[d][4 * g + 2] * inv, O[d][4 * g + 3] * inv);
      *(uint2*)(dst + d * 32 + 8 * g) = o;
    }
  __syncthreads();
#undef NGLOAD
#undef VFRAG
#undef SOFTMAX_UPDATE
#undef PACK8
}

DI void phase_da(const int wv, const Params& p, char* smem) {
  for (int idx = blockIdx.x; idx < 2304; idx += gridDim.x) {
    if (idx < 2048) {
      const int rd = idx >> 8, i = idx & 255;
      const int pr = rd * 16 + (i & 7) * 2 + (i >> 7);
      const int qb = (i >> 3) & 15;
      attn_item<0>(wv, p, pr >> 3, pr & 7, 256 + qb * 128, 36, 0, smem);
    } else {
      const int i = idx - 2048;
      const int pr = i >> 1, qb = i & 1;
      attn_item<0>(wv, p, pr >> 3, pr & 7, qb * 128, 4, 0, smem);
    }
  }
}

DI void phase_na(const int wv, const Params& p, char* smem) {
  for (int idx = blockIdx.x; idx < 2048; idx += gridDim.x) {
    const int r4 = (idx + (idx >> 8)) & 7, head = (idx >> 3) & 15, b = idx >> 7;
    na_item(wv, p, b, head, r4, smem);
  }
}

#define XB_TMO      128
#define XB_XCNT(j)  (256  + 64 * (j))
#define XB_XSUB(j)  (1280 + 64 * (j))
#define XB_XGEN(j)  (2304 + 64 * (j))
#define XB_TOP      3328
#define XB_TOPGEN   3392
#define XCD_BAR_WORDS 3456
#define XB_SPIN_CAP (1u << 18)
#define LAS __attribute__((address_space(3)))
DI unsigned xb_ld(unsigned* q)              { return __hip_atomic_load(q, __ATOMIC_RELAXED, __HIP_MEMORY_SCOPE_AGENT); }
DI unsigned xb_add(unsigned* q, unsigned v) { return __hip_atomic_fetch_add(q, v, __ATOMIC_RELAXED, __HIP_MEMORY_SCOPE_AGENT); }
DI unsigned xb_xcc_id() { return (unsigned)__builtin_amdgcn_s_getreg((3 << 11) | 20) & 0xFu; }
#define XB_SPIN(cond, bar) do { unsigned _sp = 0; while (cond) { __builtin_amdgcn_s_sleep(1); \
    if ((++_sp & 255u) == 0u) { if (xb_ld(&(bar)[XB_TMO])) break; if (_sp > XB_SPIN_CAP) { atomicAdd(&(bar)[XB_TMO], 1u); break; } } } } while (0)
struct XcdBarrier { unsigned* bar; unsigned x; volatile LAS unsigned* st; };
DI XcdBarrier xcd_barrier_post(const int wv, unsigned* bar, volatile LAS unsigned* st) {
  XcdBarrier b; b.bar = bar; b.x = xb_xcc_id(); b.st = st;
  if (wv == 0 && lane_id_() == 0) (void)xb_add(&bar[XB_XCNT(b.x)], 1u);
  return b;
}
DI void xcd_barrier_complete(unsigned* bar, unsigned x, unsigned& nloc, unsigned& nx) {
  const unsigned G = gridDim.x * gridDim.y * gridDim.z;
  unsigned sum, cnt, mine, sp = 0u;
  for (;;) {
    sum = 0u; cnt = 0u; mine = 0u;
#pragma unroll
    for (unsigned j = 0; j < 16; ++j) { const unsigned c = xb_ld(&bar[XB_XCNT(j)]); sum += c; cnt += (c > 0u) ? 1u : 0u; mine = (j == x) ? c : mine; }
    if (sum == G) break;
    __builtin_amdgcn_s_sleep(1);
    if ((++sp & 255u) == 0u) { if (xb_ld(&bar[XB_TMO])) break; if (sp > XB_SPIN_CAP) { atomicAdd(&bar[XB_TMO], 1u); break; } }
  }
  nloc = mine > 0u ? mine : 1u; nx = cnt > 0u ? cnt : 1u;
}
DI void xcd_barrier(const int wv, const XcdBarrier& b) {
  asm volatile("s_waitcnt vmcnt(0)" ::: "memory");
  __syncthreads();
  if (wv == 0 && lane_id_() == 0) {
    unsigned* bar = b.bar;
    __builtin_amdgcn_s_waitcnt(0);
    unsigned nloc = b.st[0], nx = b.st[1];
    if (nloc == 0u) { xcd_barrier_complete(bar, b.x, nloc, nx); b.st[0] = nloc; b.st[1] = nx; }
    const unsigned old = xb_add(&bar[XB_XSUB(b.x)], 1u);
    const unsigned gen = old / nloc;
    if (old + 1u == (gen + 1u) * nloc) {
      __builtin_amdgcn_fence(__ATOMIC_RELEASE, "agent");
      asm volatile("s_waitcnt vmcnt(0)" ::: "memory");
      const unsigned og = xb_add(&bar[XB_TOP], 1u);
      const unsigned tg = og / nx;
      if (og + 1u == (tg + 1u) * nx) xb_add(&bar[XB_TOPGEN], 1u);
      else XB_SPIN(xb_ld(&bar[XB_TOPGEN]) == tg, bar);
      __builtin_amdgcn_fence(__ATOMIC_ACQUIRE, "agent");
      xb_add(&bar[XB_XGEN(b.x)], 1u);
      asm volatile("s_waitcnt vmcnt(0)" ::: "memory");
    } else {
      XB_SPIN(xb_ld(&bar[XB_XGEN(b.x)]) == gen, bar);
      __builtin_amdgcn_fence(__ATOMIC_ACQUIRE, "agent");
      asm volatile("s_waitcnt vmcnt(0)" ::: "memory");
    }
  }
  __syncthreads();
}

__global__ void __launch_bounds__(512) fwd_megakernel(Params p, int ph_lo, int ph_hi) {
  __shared__ __attribute__((aligned(16))) char smem[SMEM_BYTES];
  cg::grid_group grid = cg::this_grid();
  const int wv = __builtin_amdgcn_readfirstlane((int)(threadIdx.x >> 6));
  __shared__ uint4 xb_words;
  if (threadIdx.x == 0) xb_words = make_uint4(0u, 0u, 0u, 0u);
  __syncthreads();
  XcdBarrier xb;
  xb.bar = p.bar; xb.x = 0u; xb.st = (volatile LAS unsigned*)&xb_words;
#define RUN_PHASE(n, ...)                                   \
  if (PHON(n) && ph_lo <= (n) && (n) < ph_hi) {             \
    if (DUP_PHASE == (n)) { __VA_ARGS__; grid.sync(); }     \
    __VA_ARGS__;                                            \
    if ((n) + 1 < ph_hi) {                                  \
      if ((n) == 0) { grid.sync(); xb = xcd_barrier_post(wv, p.bar, (volatile LAS unsigned*)&xb_words); } \
      else xcd_barrier(wv, xb);                             \
    }                                                       \
  }
  RUN_PHASE(0, phase_prep(wv, p, smem))
  RUN_PHASE(1, phase_norm(wv, p, p.x, p.ctx, p.norm_mix, 0, 0, 1, false))
  RUN_PHASE(2, { EpiArgs ea; ea.layer = 0; ea.res_lat = nullptr; ea.res_ctx = nullptr; ea.gate_chunk = 0;
                 phase_gemm256<EPI_QKV>(wv, p, ea, p.wqkv_t, p.xn, 1024, 12, 8, 4, false, smem); })
  RUN_PHASE(3, phase_da(wv, p, smem))
  RUN_PHASE(4, { EpiArgs ea; ea.layer = 0; ea.res_lat = p.x; ea.res_ctx = p.ctx; ea.gate_chunk = 2;
                 phase_gemm256<EPI_RES>(wv, p, ea, p.wo_t, p.xn, 1024, 4, 8, 4, false, smem, 1024, 3136); })
  RUN_PHASE(5, phase_norm(wv, p, p.out, p.hc, p.norm_ffn, 0, 3, 4, false))
  RUN_PHASE(6, { EpiArgs ea; ea.layer = 0; ea.res_lat = nullptr; ea.res_ctx = nullptr; ea.gate_chunk = 0;
                 phase_gemm256<EPI_GU>(wv, p, ea, p.wgu_t, p.xn, 1024, 22, 16, 2, false, smem); })
  RUN_PHASE(7, { EpiArgs ea; ea.layer = 0; ea.res_lat = p.out; ea.res_ctx = p.hc; ea.gate_chunk = 5;
                 phase_gemm256<EPI_RES>(wv, p, ea, p.wd_t, p.act, FF, 4, 8, 4, false, smem, 3136, 6272); })
  RUN_PHASE(8, phase_norm(wv, p, p.out, p.hc, p.norm_mix + 1024, 1, 0, 1, false))
  RUN_PHASE(9, { EpiArgs ea; ea.layer = 1; ea.res_lat = nullptr; ea.res_ctx = nullptr; ea.gate_chunk = 0;
                 phase_gemm256<EPI_QKV>(wv, p, ea, p.wqkv_t + (size_t)3072 * 1024, p.xn, 1024, 12, 8, 4, false, smem); })
  RUN_PHASE(10, phase_na(wv, p, smem))
  RUN_PHASE(11, { EpiArgs ea; ea.layer = 1; ea.res_lat = p.out; ea.res_ctx = p.hc; ea.gate_chunk = 2;
                  phase_gemm256<EPI_RES>(wv, p, ea, p.wo_t + (size_t)1024 * 1024, p.xn, 1024, 4, 8, 4, true, smem, 0, 0); })
  RUN_PHASE(12, phase_norm(wv, p, p.out, p.hc, p.norm_ffn + 1024, 1, 3, 4, true))
  RUN_PHASE(13, { EpiArgs ea; ea.layer = 1; ea.res_lat = nullptr; ea.res_ctx = nullptr; ea.gate_chunk = 0;
                  phase_gemm256<EPI_GU>(wv, p, ea, p.wgu_t + (size_t)5632 * 1024, p.xn, 1024, 22, 16, 2, true, smem); })
  RUN_PHASE(14, { EpiArgs ea; ea.layer = 1; ea.res_lat = p.out; ea.res_ctx = p.hc; ea.gate_chunk = 5;
                  phase_gemm256<EPI_RES>(wv, p, ea, p.wd_t + (size_t)1024 * FF, p.act, FF, 4, 8, 4, true, smem, 0, 0); })
  RUN_PHASE(15, phase_final_norm(wv, p))
}

extern "C" void kernel_launch(void* const* d_in, const int* in_sizes, int n_in, void* d_out, int out_size, void* d_ws, size_t ws_size,
                              hipStream_t stream) {
  static int grid_blocks = 0;
  if (!grid_blocks) {
    int dev = 0, cus = 0, per_cu = 0;
    hipGetDevice(&dev);
    hipDeviceGetAttribute(&cus, hipDeviceAttributeMultiprocessorCount, dev);
    hipOccupancyMaxActiveBlocksPerMultiprocessor(&per_cu, fwd_megakernel, 512, 0);
    if (per_cu > 1) per_cu = 1;
    grid_blocks = cus * per_cu;
    if (grid_blocks <= 0) grid_blocks = 256;
  }
  Params p{};
  p.x = (const float*)d_in[0]; p.c = (const float*)d_in[1]; p.ctx = (const float*)d_in[2]; p.c_ctx = (const float*)d_in[3];
  p.ada_w = (const float*)d_in[4]; p.ada_b = (const float*)d_in[5]; p.norm_mix = (const float*)d_in[6]; p.norm_ffn = (const float*)d_in[7];
  p.da_wqkv = (const float*)d_in[8]; p.lq1 = (const float*)d_in[9]; p.lk1 = (const float*)d_in[10]; p.lq2 = (const float*)d_in[11];
  p.lk2 = (const float*)d_in[12]; p.subln = (const float*)d_in[13]; p.da_wo = (const float*)d_in[14]; p.na_wqkv = (const float*)d_in[15];
  p.rpb = (const float*)d_in[16]; p.na_wo = (const float*)d_in[17]; p.w_gu = (const float*)d_in[18]; p.w_dn = (const float*)d_in[19];
  p.norm_final = (const float*)d_in[20];
  p.out = (float*)d_out;
  char* ws = (char*)d_ws;
  size_t off = 0;
  auto take = [&](size_t bytes) { char* r = ws + off; off += (bytes + 255) & ~(size_t)255; return r; };
  p.wqkv_t = (u16*)take((size_t)2 * 3072 * 1024 * 2);
  p.wo_t = (u16*)take((size_t)2 * 1024 * 1024 * 2);
  p.wgu_t = (u16*)take((size_t)2 * 5632 * 1024 * 2);
  p.wd_t = (u16*)take((size_t)2 * 1024 * FF * 2);
  p.mod = (float*)take((size_t)2 * 17 * 6144 * 4);
  p.tab = (float*)take(64 * 16 * 8);
  p.lam = (float*)take(256);
  p.bar = (unsigned*)take((size_t)XCD_BAR_WORDS * 4);
  p.cnt = (int*)take(512);
  p.hc = (float*)take((size_t)4096 * 1024 * 4);
  p.xn = (u16*)take((size_t)MTOT * 1024 * 2);
  p.q = (u16*)take((size_t)MTOT * 1024 * 2);
  p.k = (u16*)take((size_t)MTOT * 1024 * 2);
  p.vt = (u16*)take((size_t)MTOT * 1024 * 2);
  p.act = p.q;
#if MULTI_LAUNCH
  for (int ph = 0; ph < 16; ++ph) {
    int lo = ph, hi = ph + 1;
    void* args[] = {&p, &lo, &hi};
    hipLaunchCooperativeKernel((void*)fwd_megakernel, dim3(grid_blocks), dim3(512), args, 0, stream);
  }
#else
  int lo = 0, hi = 16;
  void* args[] = {&p, &lo, &hi};
  hipError_t e = hipLaunchCooperativeKernel((void*)fwd_megakernel, dim3(grid_blocks), dim3(512), args, 0, stream);
  if (e != hipSuccess) fprintf(stderr, "cooperative launch failed: %s (grid %d)\n", hipGetErrorString(e), grid_blocks);
#endif
}
```

```cpp
#include <hip/hip_runtime.h>
#include <hip/hip_cooperative_groups.h>
#include <cstdio>
namespace cg = cooperative_groups;

typedef unsigned short u16;
typedef __attribute__((ext_vector_type(8))) short bf16x8;
typedef __attribute__((ext_vector_type(4))) short s16x4;
typedef __attribute__((ext_vector_type(16))) float f32x16;
typedef __attribute__((ext_vector_type(2))) __bf16 bf2_t;
typedef __attribute__((ext_vector_type(2))) float f2_t;

#define DI __device__ __forceinline__
#define MFMA(a, b, c) __builtin_amdgcn_mfma_f32_32x32x16_bf16((a), (b), (c), 0, 0, 0)

#ifndef ONLYPH
#define ONLYPH -1
#endif
#define PHON(x) (ONLYPH < 0 || ONLYPH == (x))
#ifndef TNQ
#define TNQ 128
#endif
#ifndef TNR1
#define TNR1 128
#endif
#ifndef DUP_PHASE
#define DUP_PHASE -1
#endif
#ifndef MULTI_LAUNCH
#define MULTI_LAUNCH 0
#endif

constexpr int DM = 1024;
constexpr int TOKB = 2304;
constexpr int MTOT = 16 * TOKB;
constexpr int FF = 2816;
constexpr float L2E = 1.4426950408889634f;
constexpr int RPB_OFF = 135168 + 256;
constexpr int SMEM_BYTES = 135168 + 256 + 7680 + 256;

struct Params {
  const float *x, *c, *ctx, *c_ctx, *ada_w, *ada_b, *norm_mix, *norm_ffn;
  const float *da_wqkv, *lq1, *lk1, *lq2, *lk2, *subln, *da_wo, *na_wqkv, *rpb, *na_wo, *w_gu, *w_dn, *norm_final;
  float* out;
  u16 *wqkv_t, *wo_t, *wgu_t, *wd_t;
  float *mod, *tab, *lam, *hc;
  unsigned* bar;
  int* cnt;
  u16 *xn, *q, *k, *vt, *act;
};

DI int lane_id_() { return (int)__builtin_amdgcn_mbcnt_hi(~0u, __builtin_amdgcn_mbcnt_lo(~0u, 0u)); }
#define TIDX (wv * 64 + lane_id_())

DI unsigned pk2(float a, float b) {
  f2_t v = {a, b};
  bf2_t r = __builtin_convertvector(v, bf2_t);
  return __builtin_bit_cast(unsigned, r);
}
DI float silu_f(float v) { return v * __builtin_amdgcn_rcpf(1.f + __expf(-v)); }

DI void conv_tile(const int wv, const float* __restrict__ src, int K, int N, u16* __restrict__ dst, int perm, int tile, char* smem) {
  float* ts = (float*)smem;
  const int tid = TIDX;
  const int nkt = K >> 6;
  const int kt = tile % nkt, ntile = tile / nkt;
  const int k0 = kt * 64, n0 = ntile * 64;
  __syncthreads();
#pragma unroll
  for (int i = 0; i < 8; ++i) {
    int kk = wv + 8 * i, n = lane_id_();
    ts[kk * 65 + n] = src[(size_t)(k0 + kk) * N + n0 + n];
  }
  __syncthreads();
  const int n = tid >> 3, kc = tid & 7;
  float v[8];
#pragma unroll
  for (int j = 0; j < 8; ++j) v[j] = ts[(kc * 8 + j) * 65 + n];
  int nn = n0 + n;
  if (perm) {
    int half = nn >= FF ? 1 : 0;
    int cc = nn - half * FF;
    nn = (cc >> 4) * 32 + half * 16 + (cc & 15);
  }
  uint4 o;
  o.x = pk2(v[0], v[1]); o.y = pk2(v[2], v[3]); o.z = pk2(v[4], v[5]); o.w = pk2(v[6], v[7]);
  *(uint4*)(dst + (size_t)nn * K + k0 + kc * 8) = o;
}

DI void mod_item(const int wv, const Params& p, int item, char* smem) {
  const int l = item / 96, n0 = (item % 96) * 64;
  float* sc = (float*)smem;
  float* red = (float*)(smem + 81920);
  const int lane = lane_id_(), w = wv, tid = w * 64 + lane;
  __syncthreads();
  for (int e = tid; e < 17 * 1024; e += 512) {
    int r = e >> 10, kk = e & 1023;
    float v = (r < 16) ? p.c[r * 1024 + kk] : p.c_ctx[kk];
    sc[kk * 20 + r] = silu_f(v);
  }
  __syncthreads();
  float acc[17];
#pragma unroll
  for (int r = 0; r < 17; ++r) acc[r] = 0.f;
  const float* wp = p.ada_w + ((size_t)l * 1024 + w * 128) * 6144 + n0 + lane;
#pragma unroll 16
  for (int kk = 0; kk < 128; ++kk) {
    float wv = wp[(size_t)kk * 6144];
    const float4* s4 = (const float4*)(sc + (w * 128 + kk) * 20);
    float4 a0 = s4[0], a1 = s4[1], a2 = s4[2], a3 = s4[3];
    float a16 = sc[(w * 128 + kk) * 20 + 16];
    acc[0] += a0.x * wv; acc[1] += a0.y * wv; acc[2] += a0.z * wv; acc[3] += a0.w * wv;
    acc[4] += a1.x * wv; acc[5] += a1.y * wv; acc[6] += a1.z * wv; acc[7] += a1.w * wv;
    acc[8] += a2.x * wv; acc[9] += a2.y * wv; acc[10] += a2.z * wv; acc[11] += a2.w * wv;
    acc[12] += a3.x * wv; acc[13] += a3.y * wv; acc[14] += a3.z * wv; acc[15] += a3.w * wv;
    acc[16] += a16 * wv;
  }
#pragma unroll
  for (int r = 0; r < 17; ++r) red[(w * 17 + r) * 64 + lane] = acc[r];
  __syncthreads();
  for (int e = tid; e < 17 * 64; e += 512) {
    int r = e >> 6, nl = e & 63;
    float s = 0.f;
#pragma unroll
    for (int ww = 0; ww < 8; ++ww) s += red[(ww * 17 + r) * 64 + nl];
    s += p.ada_b[l * 6144 + n0 + nl];
    p.mod[((size_t)l * 17 + r) * 6144 + n0 + nl] = s;
  }
}

DI void table_item(const int wv, const Params& p) {
  const int tid = TIDX;
  for (int e = tid; e < 3456; e += 512) p.bar[e] = 0u;
  if (tid < 128) p.cnt[tid] = 0;
  for (int e = tid; e < 1024; e += 512) {
    int pos = e >> 4, f = e & 15;
    float freq = powf(10000.f, -(float)f / 16.f);
    float ang = (float)pos * freq;
    float sn, cs;
    sincosf(ang, &sn, &cs);
    p.tab[e * 2] = cs;
    p.tab[e * 2 + 1] = sn;
  }
  if (tid < 64) {
    float a = p.lq1[tid] * p.lk1[tid];
    float b = p.lq2[tid] * p.lk2[tid];
#pragma unroll
    for (int o = 32; o > 0; o >>= 1) { a += __shfl_xor(a, o); b += __shfl_xor(b, o); }
    if (tid == 0) p.lam[0] = expf(a) - expf(b) + 0.2f;
  }
}

DI void conv_list_tile(const int wv, const Params& p, int t, char* smem) {
  const int l = t / 3136;
  t -= l * 3136;
  if (t < 768) {
    conv_tile(wv, l == 0 ? p.da_wqkv : p.na_wqkv, 1024, 3072, p.wqkv_t + (size_t)l * 3072 * 1024, 0, t, smem);
  } else if (t < 1024) {
    conv_tile(wv, l == 0 ? p.da_wo : p.na_wo, 1024, 1024, p.wo_t + (size_t)l * 1024 * 1024, 0, t - 768, smem);
  } else if (t < 2432) {
    conv_tile(wv, p.w_gu + (size_t)l * 1024 * 5632, 1024, 5632, p.wgu_t + (size_t)l * 5632 * 1024, 1, t - 1024, smem);
  } else {
    conv_tile(wv, p.w_dn + (size_t)l * FF * 1024, FF, 1024, p.wd_t + (size_t)l * 1024 * FF, 0, t - 2432, smem);
  }
}

DI void phase_prep(const int wv, const Params& p, char* smem) {
  const int total = 192 + 1 + 1024;
  for (int it = blockIdx.x; it < total; it += gridDim.x) {
    if (it < 192) { mod_item(wv, p, it, smem); continue; }
    if (it == 192) { table_item(wv, p); continue; }
    conv_list_tile(wv, p, it - 193, smem);
  }
}

struct NormSpec {
  int kind;
  const float* gw;
  int layer, ch_shift, ch_scale;
};
DI void norm_one_row(const Params& p, const NormSpec& ns, int row, int lane) {
  const int b = row / TOKB, j = row - b * TOKB;
  float* src = (j < 256) ? p.hc + ((size_t)b * 256 + j) * DM : p.out + ((size_t)b * 2048 + (j - 256)) * DM;
  float4 v[4];
  float ss = 0.f;
#pragma unroll
  for (int i = 0; i < 4; ++i) {
    v[i] = *(const float4*)(src + i * 256 + lane * 4);
    ss += v[i].x * v[i].x + v[i].y * v[i].y + v[i].z * v[i].z + v[i].w * v[i].w;
  }
#pragma unroll
  for (int o = 32; o > 0; o >>= 1) ss += __shfl_xor(ss, o);
  const float r = rsqrtf(ss * (1.f / 1024.f) + 1e-6f);
  if (ns.kind == 1) {
    const int mr = (j < 256) ? 16 : b;
    const float* sh = p.mod + ((size_t)ns.layer * 17 + mr) * 6144 + ns.ch_shift * 1024;
    const float* sc = p.mod + ((size_t)ns.layer * 17 + mr) * 6144 + ns.ch_scale * 1024;
    u16* dst = p.xn + (size_t)row * DM;
#pragma unroll
    for (int i = 0; i < 4; ++i) {
      const int n = i * 256 + lane * 4;
      float4 g = *(const float4*)(ns.gw + n);
      float4 s1 = *(const float4*)(sc + n);
      float4 s0 = *(const float4*)(sh + n);
      float y0 = v[i].x * r * g.x * (1.f + s1.x) + s0.x;
      float y1 = v[i].y * r * g.y * (1.f + s1.y) + s0.y;
      float y2 = v[i].z * r * g.z * (1.f + s1.z) + s0.z;
      float y3 = v[i].w * r * g.w * (1.f + s1.w) + s0.w;
      uint2 o; o.x = pk2(y0, y1); o.y = pk2(y2, y3);
      *(uint2*)(dst + n) = o;
    }
  } else {
#pragma unroll
    for (int i = 0; i < 4; ++i) {
      const int n = i * 256 + lane * 4;
      float4 g = *(const float4*)(ns.gw + n);
      float4 o;
      o.x = v[i].x * r * g.x; o.y = v[i].y * r * g.y; o.z = v[i].z * r * g.z; o.w = v[i].w * r * g.w;
      *(float4*)(src + n) = o;
    }
  }
}

DI void phase_norm(const int wv, const Params& p, const float* __restrict__ lat, const float* __restrict__ cx, const float* __restrict__ gw,
                   int layer, int ch_shift, int ch_scale, bool lat_only) {
  const int lane = lane_id_(), w = wv;
  for (int row0 = blockIdx.x * 32 + w * 4; row0 < MTOT; row0 += gridDim.x * 32) {
    const int b = row0 / TOKB, j = row0 - b * TOKB;
    if (lat_only && j < 256) continue;
    const float* src = (j < 256) ? cx + ((size_t)b * 256 + j) * DM : lat + ((size_t)b * 2048 + (j - 256)) * DM;
    const int mr = (j < 256) ? 16 : b;
    const float* sh = p.mod + ((size_t)layer * 17 + mr) * 6144 + ch_shift * 1024;
    const float* sc = p.mod + ((size_t)layer * 17 + mr) * 6144 + ch_scale * 1024;
    float4 v0[4], v1[4], v2[4], v3[4];
#pragma unroll
    for (int i = 0; i < 4; ++i) v0[i] = *(const float4*)(src + i * 256 + lane * 4);
#pragma unroll
    for (int i = 0; i < 4; ++i) v1[i] = *(const float4*)(src + DM + i * 256 + lane * 4);
#pragma unroll
    for (int i = 0; i < 4; ++i) v2[i] = *(const float4*)(src + 2 * DM + i * 256 + lane * 4);
#pragma unroll
    for (int i = 0; i < 4; ++i) v3[i] = *(const float4*)(src + 3 * DM + i * 256 + lane * 4);
    float s0 = 0.f, s1 = 0.f, s2 = 0.f, s3 = 0.f;
#pragma unroll
    for (int i = 0; i < 4; ++i) {
      s0 += v0[i].x * v0[i].x + v0[i].y * v0[i].y + v0[i].z * v0[i].z + v0[i].w * v0[i].w;
      s1 += v1[i].x * v1[i].x + v1[i].y * v1[i].y + v1[i].z * v1[i].z + v1[i].w * v1[i].w;
      s2 += v2[i].x * v2[i].x + v2[i].y * v2[i].y + v2[i].z * v2[i].z + v2[i].w * v2[i].w;
      s3 += v3[i].x * v3[i].x + v3[i].y * v3[i].y + v3[i].z * v3[i].z + v3[i].w * v3[i].w;
    }
#pragma unroll
    for (int o = 32; o > 0; o >>= 1) { s0 += __shfl_xor(s0, o); s1 += __shfl_xor(s1, o); s2 += __shfl_xor(s2, o); s3 += __shfl_xor(s3, o); }
    const float r0 = rsqrtf(s0 * (1.f / 1024.f) + 1e-6f), r1 = rsqrtf(s1 * (1.f / 1024.f) + 1e-6f);
    const float r2 = rsqrtf(s2 * (1.f / 1024.f) + 1e-6f), r3 = rsqrtf(s3 * (1.f / 1024.f) + 1e-6f);
    u16* dst = p.xn + (size_t)row0 * DM;
#pragma unroll
    for (int i = 0; i < 4; ++i) {
      const int n = i * 256 + lane * 4;
      const float4 g = *(const float4*)(gw + n);
      const float4 c1 = *(const float4*)(sc + n);
      const float4 c0 = *(const float4*)(sh + n);
      const float m0 = g.x * (1.f + c1.x), m1 = g.y * (1.f + c1.y), m2 = g.z * (1.f + c1.z), m3 = g.w * (1.f + c1.w);
      uint2 o;
#define NROW(v_, r_, k_)                                                                   \
      o.x = pk2(v_[i].x * r_ * m0 + c0.x, v_[i].y * r_ * m1 + c0.y);                        \
      o.y = pk2(v_[i].z * r_ * m2 + c0.z, v_[i].w * r_ * m3 + c0.w);                        \
      *(uint2*)(dst + (k_) * DM + n) = o;
      NROW(v0, r0, 0) NROW(v1, r1, 1) NROW(v2, r2, 2) NROW(v3, r3, 3)
#undef NROW
    }
  }
}

DI void phase_final_norm(const int wv, const Params& p) {
  const int lane = lane_id_(), w = wv;
  for (int row0 = blockIdx.x * 16 + w * 2; row0 < 32768; row0 += gridDim.x * 16) {
    float* src = p.out + (size_t)row0 * DM;
    float4 va[4], vb[4];
#pragma unroll
    for (int i = 0; i < 4; ++i) va[i] = *(const float4*)(src + i * 256 + lane * 4);
#pragma unroll
    for (int i = 0; i < 4; ++i) vb[i] = *(const float4*)(src + DM + i * 256 + lane * 4);
    float sa = 0.f, sb2 = 0.f;
#pragma unroll
    for (int i = 0; i < 4; ++i) {
      sa += va[i].x * va[i].x + va[i].y * va[i].y + va[i].z * va[i].z + va[i].w * va[i].w;
      sb2 += vb[i].x * vb[i].x + vb[i].y * vb[i].y + vb[i].z * vb[i].z + vb[i].w * vb[i].w;
    }
#pragma unroll
    for (int o = 32; o > 0; o >>= 1) { sa += __shfl_xor(sa, o); sb2 += __shfl_xor(sb2, o); }
    const float ra = rsqrtf(sa * (1.f / 1024.f) + 1e-6f);
    const float rb = rsqrtf(sb2 * (1.f / 1024.f) + 1e-6f);
#pragma unroll
    for (int i = 0; i < 4; ++i) {
      const int n = i * 256 + lane * 4;
      const float4 g = *(const float4*)(p.norm_final + n);
      float4 o;
      o.x = va[i].x * ra * g.x; o.y = va[i].y * ra * g.y; o.z = va[i].z * ra * g.z; o.w = va[i].w * ra * g.w;
      *(float4*)(src + n) = o;
      o.x = vb[i].x * rb * g.x; o.y = vb[i].y * rb * g.y; o.z = vb[i].z * rb * g.z; o.w = vb[i].w * rb * g.w;
      *(float4*)(src + DM + n) = o;
    }
  }
}

enum { EPI_QKV = 0, EPI_RES = 1, EPI_GU = 2 };

struct EpiArgs {
  int layer;
  const float* res_lat;
  const float* res_ctx;
  int gate_chunk;
};

template <int EPI>
DI void epilogue(const Params& p, const EpiArgs& ea, const f32x16& acc, int n0, int b, int j, int hh) {
  const size_t m = (size_t)b * TOKB + j;
  if (EPI == EPI_QKV) {
    const int part = n0 >> 10, nn = n0 & 1023;
    if (part < 2) {
      float v[16];
#pragma unroll
      for (int i = 0; i < 16; ++i) v[i] = acc[i];
      if (ea.layer == 0 && j >= 256) {
        const int t = j - 256;
        const int pos = ((n0 & 32) == 0) ? (t >> 6) : (t & 63);
        const float2* tb = (const float2*)p.tab + pos * 16;
#pragma unroll
        for (int i = 0; i < 8; ++i) {
          const int f = (i & 3) + 8 * (i >> 2) + 4 * hh;
          float2 cs = tb[f];
          float a = v[i], bb = v[i + 8];
          v[i] = a * cs.x - bb * cs.y;
          v[i + 8] = bb * cs.x + a * cs.y;
        }
      }
      if (part == 0) {
#pragma unroll
        for (int i = 0; i < 16; ++i) v[i] *= 0.125f;
      }
      u16* dst = (part == 0 ? p.q : p.k) + m * DM + nn + 4 * hh;
#pragma unroll
      for (int g = 0; g < 4; ++g) {
        uint2 o; o.x = pk2(v[4 * g], v[4 * g + 1]); o.y = pk2(v[4 * g + 2], v[4 * g + 3]);
        *(uint2*)(dst + 8 * g) = o;
      }
    } else {
      u16* dst = p.vt + ((size_t)b * 1024 + nn + 4 * hh) * TOKB + j;
#pragma unroll
      for (int i = 0; i < 16; ++i) {
        const int rr = (i & 3) + 8 * (i >> 2);
        dst[(size_t)rr * TOKB] = (u16)(pk2(acc[i], 0.f) & 0xffffu);
      }
    }
  } else if (EPI == EPI_RES) {
    const bool isctx = j < 256;
    const size_t ro = isctx ? ((size_t)b * 256 + j) * DM : ((size_t)b * 2048 + (j - 256)) * DM;
    const float* src = (isctx ? ea.res_ctx : ea.res_lat) + ro;
    float* dst = (isctx ? p.hc : p.out) + ro;
    const float* gate = p.mod + ((size_t)ea.layer * 17 + (isctx ? 16 : b)) * 6144 + ea.gate_chunk * 1024;
#pragma unroll
    for (int g = 0; g < 4; ++g) {
      const int n = n0 + 8 * g + 4 * hh;
      float4 hv = *(const float4*)(src + n);
      float4 gt = *(const float4*)(gate + n);
      hv.x += gt.x * acc[4 * g]; hv.y += gt.y * acc[4 * g + 1]; hv.z += gt.z * acc[4 * g + 2]; hv.w += gt.w * acc[4 * g + 3];
      *(float4*)(dst + n) = hv;
    }
  } else {
    u16* dst = p.act + m * FF + (n0 >> 5) * 16 + 4 * hh;
#pragma unroll
    for (int g = 0; g < 2; ++g) {
      float a0 = silu_f(acc[4 * g]) * acc[4 * g + 8];
      float a1 = silu_f(acc[4 * g + 1]) * acc[4 * g + 9];
      float a2 = silu_f(acc[4 * g + 2]) * acc[4 * g + 10];
      float a3 = silu_f(acc[4 * g + 3]) * acc[4 * g + 11];
      uint2 o; o.x = pk2(a0, a1); o.y = pk2(a2, a3);
      *(uint2*)(dst + 8 * g) = o;
    }
  }
}

DI void stage_store_bf16(char* lw, int lane, const uint2 v0, const uint2 v1, const uint2 v2, const uint2 v3, const uint2 v4,
                         const uint2 v5, const uint2 v6, const uint2 v7, u16* gdst, size_t ld) {
  const int l31 = lane & 31, hh = lane >> 5;
  char* wp = lw + l31 * 136 + hh * 8;
  *(uint2*)(wp) = v0;       *(uint2*)(wp + 16) = v1;  *(uint2*)(wp + 32) = v2;  *(uint2*)(wp + 48) = v3;
  *(uint2*)(wp + 64) = v4;  *(uint2*)(wp + 80) = v5;  *(uint2*)(wp + 96) = v6;  *(uint2*)(wp + 112) = v7;
#pragma unroll
  for (int k = 0; k < 4; ++k) {
    const int c = lane + 64 * k;
    const int row = c >> 3, cc = c & 7;
    const uint2 lo = *(const uint2*)(lw + row * 136 + cc * 16);
    const uint2 hi = *(const uint2*)(lw + row * 136 + cc * 16 + 8);
    *(uint4*)(gdst + (size_t)row * ld + cc * 8) = make_uint4(lo.x, lo.y, hi.x, hi.y);
  }
}
DI void stage_res_f32(char* lw, int lane, const f32x16& acc, const float* gsrc, float* gdst, const float* gate) {
  const int l31 = lane & 31, hh = lane >> 5;
  char* wp = lw + l31 * 144 + hh * 16;
#pragma unroll
  for (int g = 0; g < 4; ++g) *(float4*)(wp + g * 32) = make_float4(acc[4 * g], acc[4 * g + 1], acc[4 * g + 2], acc[4 * g + 3]);
#pragma unroll
  for (int k = 0; k < 4; ++k) {
    const int c = lane + 64 * k;
    const int row = c >> 3, cc = c & 7;
    const float4 a = *(const float4*)(lw + row * 144 + cc * 16);
    const float4 gt = *(const float4*)(gate + cc * 4);
    float4 hv = *(const float4*)(gsrc + (size_t)row * DM + cc * 4);
    hv.x += gt.x * a.x; hv.y += gt.y * a.y; hv.z += gt.z * a.z; hv.w += gt.w * a.w;
    *(float4*)(gdst + (size_t)row * DM + cc * 4) = hv;
  }
}

typedef __attribute__((ext_vector_type(4))) unsigned u32x4;
struct Stage { u32x4 x0, x1, x2, x3, w0, w1, w2, w3; };

template <int EPI, int TN>
DI void phase_gemm(const int wv, const Params& p, const EpiArgs& ea, const u16* __restrict__ Wt, const u16* __restrict__ X, const int K, const int ntn,
                   const bool lat_only, char* smem) {
  constexpr int NT2 = TN / 64;
  constexpr int STG = (256 + TN) * 128;
  constexpr int WOFF = 32768;
  const int lane = lane_id_(), w = wv, tid = w * 64 + lane, l31 = lane & 31, hh = lane >> 5;
  const int wm = w & 3, wn = w >> 2;
  const int lc = tid & 7, lr = tid >> 3;
  const int nmt = lat_only ? 128 : 144;
  const int total = nmt * ntn;
  const int nk = K >> 6;
  if ((int)blockIdx.x >= total) return;
  const int my_tiles = (total - (int)blockIdx.x + (int)gridDim.x - 1) / (int)gridDim.x;
  const int nitems = my_tiles * nk;
  const unsigned st_off = lr * 128 + ((lc ^ ((lr >> 1) & 7)) << 4);
  const unsigned sw = (l31 >> 1) & 7;
  const unsigned xr_off = (wm * 64 + l31) * 128;
  const unsigned wr_off = WOFF + (wn * (TN / 2) + l31) * 128;
  char* const buf0 = smem;
  char* const buf1 = smem + STG;

  int lt = blockIdx.x, lko = 0;
  const u16 *xg, *wg;
#define SETP(t_)                                                            \
  {                                                                         \
    const int mi_ = (t_) / ntn, nt_ = (t_) - mi_ * ntn;                     \
    const int mt_ = lat_only ? (mi_ >> 3) * 9 + 1 + (mi_ & 7) : mi_;        \
    xg = X + (size_t)(mt_ * 256 + lr) * K + lc * 8;                         \
    wg = Wt + (size_t)(nt_ * TN + lr) * K + lc * 8;                         \
  }
#define LOADS(s_)                                                           \
  {                                                                         \
    s_.x0 = *(const u32x4*)(xg + lko);                                      \
    s_.x1 = *(const u32x4*)(xg + (size_t)64 * K + lko);                     \
    s_.x2 = *(const u32x4*)(xg + (size_t)128 * K + lko);                    \
    s_.x3 = *(const u32x4*)(xg + (size_t)192 * K + lko);                    \
    s_.w0 = *(const u32x4*)(wg + lko);                                      \
    s_.w1 = *(const u32x4*)(wg + (size_t)64 * K + lko);                     \
    if (TN > 128) {                                                         \
      s_.w2 = *(const u32x4*)(wg + (size_t)128 * K + lko);                  \
      s_.w3 = *(const u32x4*)(wg + (size_t)192 * K + lko);                  \
    }                                                                       \
    lko += 64;                                                              \
    if (lko == K) {                                                         \
      lko = 0;                                                              \
      if (lt + (int)gridDim.x < total) lt += gridDim.x;                     \
      SETP(lt);                                                             \
    }                                                                       \
  }
#define STORES(s_, sb_)                                                     \
  {                                                                         \
    *(u32x4*)((sb_) + st_off) = s_.x0;                                      \
    *(u32x4*)((sb_) + st_off + 8192) = s_.x1;                               \
    *(u32x4*)((sb_) + st_off + 16384) = s_.x2;                              \
    *(u32x4*)((sb_) + st_off + 24576) = s_.x3;                              \
    *(u32x4*)((sb_) + WOFF + st_off) = s_.w0;                               \
    *(u32x4*)((sb_) + WOFF + st_off + 8192) = s_.w1;                        \
    if (TN > 128) {                                                         \
      *(u32x4*)((sb_) + WOFF + st_off + 16384) = s_.w2;                     \
      *(u32x4*)((sb_) + WOFF + st_off + 24576) = s_.w3;                     \
    }                                                                       \
  }
#define RD(sb_, ks_, F_)                                                                        \
  {                                                                                             \
    const unsigned co_ = ((unsigned)((ks_) * 2 + hh) ^ sw) << 4;                                \
    F_.q0 = *(const bf16x8*)((sb_) + xr_off + co_);                                             \
    F_.q1 = *(const bf16x8*)((sb_) + xr_off + 4096 + co_);                                      \
    F_.p0 = *(const bf16x8*)((sb_) + wr_off + co_);                                             \
    F_.p1 = *(const bf16x8*)((sb_) + wr_off + 4096 + co_);                                      \
  }
#define MM(F_)                                                                                  \
  {                                                                                             \
    acc[0][0] = MFMA(F_.p0, F_.q0, acc[0][0]);                                                  \
    acc[0][1] = MFMA(F_.p0, F_.q1, acc[0][1]);                                                  \
    acc[1][0] = MFMA(F_.p1, F_.q0, acc[1][0]);                                                  \
    acc[1][1] = MFMA(F_.p1, F_.q1, acc[1][1]);                                                  \
  }
#define SB __builtin_amdgcn_sched_barrier(0)
#define ITEM(rb_, sset_, wb_)                                                                   \
  {                                                                                             \
    RD(rb_, 0, F0); RD(rb_, 1, F1); SB;                                                         \
    MM(F0); RD(rb_, 2, F2); SB;                                                                 \
    MM(F1); RD(rb_, 3, F3); SB;                                                                 \
    STORES(sset_, wb_); LOADS(sset_); SB;                                                       \
    MM(F2); SB;                                                                                 \
    MM(F3); SB;                                                                                 \
    __syncthreads();                                                                            \
    ++g;                                                                                        \
  }

  static_assert(TN == 128, "wave tile is 64x64");
  struct Frag { bf16x8 p0, p1, q0, q1; };
  Frag F0, F1, F2, F3;
  Stage sA, sB;
  sA.w2 = sA.w3 = sB.w2 = sB.w3 = (u32x4){0u, 0u, 0u, 0u};
  SETP(lt);
  LOADS(sA);
  LOADS(sB);
  __syncthreads();
  STORES(sA, buf0);
  LOADS(sA);
  __syncthreads();
  int g = 0;
  for (int ct = blockIdx.x; ct < total; ct += gridDim.x) {
    f32x16 acc[NT2][2];
#pragma unroll
    for (int a = 0; a < NT2; ++a)
#pragma unroll
      for (int bq = 0; bq < 2; ++bq)
#pragma unroll
        for (int i = 0; i < 16; ++i) acc[a][bq][i] = 0.f;
    for (int kt = 0; kt < nk; kt += 2) {
      ITEM(buf0, sB, buf1);
      ITEM(buf1, sA, buf0);
    }
    const int mi = ct / ntn, nt = ct - mi * ntn;
    const int mt = lat_only ? (mi >> 3) * 9 + 1 + (mi & 7) : mi;
    const int b = mt / 9;
    const int jb = (mt - b * 9) * 256 + wm * 64 + l31;
#pragma unroll
    for (int a = 0; a < NT2; ++a)
#pragma unroll
      for (int bq = 0; bq < 2; ++bq)
        epilogue<EPI>(p, ea, acc[a][bq], nt * TN + wn * (TN / 2) + a * 32, b, jb + bq * 32, hh);
  }
#undef SETP
#undef LOADS
#undef STORES
#undef RD
#undef MM
#undef ITEM
}

DI bool tile_of(int r, int nmt, int NN, int GM, int GN, int& mi, int& nt) {
  if (gridDim.x == 256) {
    const int x = blockIdx.x & 7, sl = blockIdx.x >> 3;
    const int NG = NN / GN;
    const int c = r * 8 + x;
    if (c >= (nmt / GM) * NG) return false;
    const int mg = c / NG, ng = c - mg * NG;
    const int sm = sl / GN;
    mi = mg * GM + sm;
    nt = ng * GN + (sl - sm * GN);
    return true;
  }
  const int t = r * gridDim.x + blockIdx.x;
  if (t >= nmt * NN) return false;
  mi = t / NN;
  nt = t - mi * NN;
  return true;
}

template <int EPI>
DI void phase_gemm256(const int wv, const Params& p, const EpiArgs& ea, const u16* __restrict__ Wt, const u16* __restrict__ X, const int K, const int NN,
                      const int GM, const int GN, const bool lat_only, char* smem, const int tail_lo = 0, const int tail_hi = 0,
                      const NormSpec ns = NormSpec{0, nullptr, 0, 0, 0}, int* cnt = nullptr) {
  constexpr int STG = 65536;
  constexpr int WOFF = 32768;
  const int lane = lane_id_(), w = wv, tid = w * 64 + lane, l31 = lane & 31, hh = lane >> 5;
  const int wm = w & 3, wn = w >> 2;
  const int lc = tid & 7, lr = tid >> 3;
  const int nmt = lat_only ? 128 : 144;
  const int nk = K >> 6;
  int nr = 0;
  {
    int a_, b_;
    while (tile_of(nr, nmt, NN, GM, GN, a_, b_)) ++nr;
  }
  int tw_rank = blockIdx.x, tw_cnt = gridDim.x;
  if (tail_hi > tail_lo && gridDim.x == 256) {
    const int nchunks = (nmt / GM) * (NN / GN);
    const int nrmax = (nchunks + 7) >> 3;
    int nidle = 0, before = 0;
    for (int x = 0; x < 8; ++x) {
      const int nrx = x < nchunks ? (nchunks - x + 7) >> 3 : 0;
      if (nrx < nrmax) { if (x < (int)(blockIdx.x & 7)) ++before; ++nidle; }
    }
    if (nidle > 0) {
      tw_cnt = nidle * 32;
      tw_rank = (nr < nrmax) ? before * 32 + (int)(blockIdx.x >> 3) : -1;
    }
  }
#define TAIL_WORK()                                                                   \
  if (tail_hi > tail_lo && tw_rank >= 0) {                                            \
    for (int tt_ = tail_lo + tw_rank; tt_ < tail_hi; tt_ += tw_cnt) conv_list_tile(wv, p, tt_, smem); \
  }
  if (nr == 0) { TAIL_WORK(); return; }
  const unsigned st_off = lr * 128 + ((lc ^ ((lr >> 1) & 7)) << 4);
  const unsigned sw = (l31 >> 1) & 7;
  const unsigned xr_off = (wm * 64 + l31) * 128;
  const unsigned wr_off = WOFF + (wn * 128 + l31) * 128;
  char* const buf0 = smem;
  char* const buf1 = smem + STG;

  int lrd = 0, lko = 0;
  const u16 *xg, *wg;
  const int gch = (lane & 7) ^ (((lane >> 4) + 4 * w) & 7);
  const unsigned lds_w = w * 1024;
#define SETP(r_)                                                            \
  {                                                                         \
    int mi_, nt_;                                                           \
    tile_of((r_), nmt, NN, GM, GN, mi_, nt_);                               \
    const int mt_ = lat_only ? (mi_ >> 3) * 9 + 1 + (mi_ & 7) : mi_;        \
    xg = X + (size_t)(mt_ * 256 + lr) * K + gch * 8;                        \
    wg = Wt + (size_t)(nt_ * 256 + lr) * K + gch * 8;                       \
  }
#define GL1(g_, l_) __builtin_amdgcn_global_load_lds((const unsigned*)(g_), (unsigned*)(l_), 16, 0, 0)
#define GLDS_X(sb_)                                                         \
  {                                                                         \
    GL1(xg + lko, (sb_) + lds_w);                                           \
    GL1(xg + (size_t)64 * K + lko, (sb_) + lds_w + 8192);                   \
    GL1(xg + (size_t)128 * K + lko, (sb_) + lds_w + 16384);                 \
    GL1(xg + (size_t)192 * K + lko, (sb_) + lds_w + 24576);                 \
  }
#define GLDS_W(sb_)                                                         \
  {                                                                         \
    GL1(wg + lko, (sb_) + WOFF + lds_w);                                    \
    GL1(wg + (size_t)64 * K + lko, (sb_) + WOFF + lds_w + 8192);            \
    GL1(wg + (size_t)128 * K + lko, (sb_) + WOFF + lds_w + 16384);          \
    GL1(wg + (size_t)192 * K + lko, (sb_) + WOFF + lds_w + 24576);          \
    lko += 64;                                                              \
    if (lko == K) {                                                         \
      lko = 0;                                                              \
      if (lrd + 1 < nr) ++lrd;                                              \
      SETP(lrd);                                                            \
    }                                                                       \
  }
#define GLDS(sb_) { GLDS_X(sb_); GLDS_W(sb_); }
#define WAITV0 asm volatile("s_waitcnt vmcnt(0)" ::: "memory")
#define RD(sb_, ks_, F_)                                                                        \
  {                                                                                             \
    const unsigned co_ = ((unsigned)((ks_) * 2 + hh) ^ sw) << 4;                                \
    F_.q0 = *(const bf16x8*)((sb_) + xr_off + co_);                                             \
    F_.q1 = *(const bf16x8*)((sb_) + xr_off + 4096 + co_);                                      \
    F_.p0 = *(const bf16x8*)((sb_) + wr_off + co_);                                             \
    F_.p1 = *(const bf16x8*)((sb_) + wr_off + 4096 + co_);                                      \
    F_.p2 = *(const bf16x8*)((sb_) + wr_off + 8192 + co_);                                      \
    F_.p3 = *(const bf16x8*)((sb_) + wr_off + 12288 + co_);                                     \
  }
#define MM1(F_)                                                                                 \
  {                                                                                             \
    acc[0][0] = MFMA(F_.p0, F_.q0, acc[0][0]);                                                  \
  }
#define MM7(F_)                                                                                 \
  {                                                                                             \
    acc[0][1] = MFMA(F_.p0, F_.q1, acc[0][1]);                                                  \
    acc[1][0] = MFMA(F_.p1, F_.q0, acc[1][0]);                                                  \
    acc[1][1] = MFMA(F_.p1, F_.q1, acc[1][1]);                                                  \
    acc[2][0] = MFMA(F_.p2, F_.q0, acc[2][0]);                                                  \
    acc[2][1] = MFMA(F_.p2, F_.q1, acc[2][1]);                                                  \
    acc[3][0] = MFMA(F_.p3, F_.q0, acc[3][0]);                                                  \
    acc[3][1] = MFMA(F_.p3, F_.q1, acc[3][1]);                                                  \
  }
#define ITEM(rb_, wb_)                                                                          \
  {                                                                                             \
    if (early) GLDS_X(wb_);                                                                     \
    MM1(FA); SB;                                                                                \
    if (early) GLDS_W(wb_);                                                                     \
    RD(rb_, 1, FB); SB; MM7(FA); SB;                                                            \
    if (!early) GLDS_X(wb_);                                                                    \
    MM1(FB); SB;                                                                                \
    if (!early) GLDS_W(wb_);                                                                    \
    RD(rb_, 2, FA); SB; MM7(FB); SB;                                                            \
    MM1(FA); SB; RD(rb_, 3, FB); SB; MM7(FA); SB;                                               \
    WAITV0;                                                                                     \
    __syncthreads();                                                                            \
    MM1(FB); SB; RD(wb_, 0, FA); SB; MM7(FB); SB;                                               \
  }

  struct Frag6 { bf16x8 p0, p1, p2, p3, q0, q1; };
  Frag6 FA, FB;
  const bool early = w < 4;
  SETP(0);
  __syncthreads();
  GLDS(buf0);
  WAITV0;
  __syncthreads();
  RD(buf0, 0, FA);
  for (int r = 0; r < nr; ++r) {
    f32x16 acc[4][2];
#pragma unroll
    for (int a = 0; a < 4; ++a)
#pragma unroll
      for (int bq = 0; bq < 2; ++bq)
#pragma unroll
        for (int i = 0; i < 16; ++i) acc[a][bq][i] = 0.f;
    for (int kt = 0; kt < nk; kt += 2) {
      ITEM(buf0, buf1);
      ITEM(buf1, buf0);
    }
    int mi, nt;
    tile_of(r, nmt, NN, GM, GN, mi, nt);
    const int mt = lat_only ? (mi >> 3) * 9 + 1 + (mi & 7) : mi;
    const int b = mt / 9;
    const int jb = (mt - b * 9) * 256 + wm * 64 + l31;
    char* const lw = buf1 + w * 8192;
    const int jw = (mt - b * 9) * 256 + wm * 64;
    const int nw = nt * 256 + wn * 128;
    if (EPI == EPI_QKV && nw >= 2048) {
#pragma unroll
      for (int a = 0; a < 4; ++a)
#pragma unroll
        for (int bq = 0; bq < 2; ++bq)
          epilogue<EPI>(p, ea, acc[a][bq], nw + a * 32, b, jb + bq * 32, hh);
    } else if (EPI == EPI_QKV) {
      const int part = nw >> 10, nn = nw & 1023;
      const bool rope = (ea.layer == 0) && (jw >= 256);
      const float qs = part == 0 ? 0.125f : 1.f;
      u16* const dbase = (part == 0 ? p.q : p.k) + ((size_t)b * TOKB + jw) * DM + nn;
#pragma unroll
      for (int bq = 0; bq < 2; ++bq) {
        const int t = jw + bq * 32 + l31 - 256;
#pragma unroll
        for (int hf = 0; hf < 2; ++hf) {
          uint2 pk[8];
#pragma unroll
          for (int a2 = 0; a2 < 2; ++a2) {
            const int a = hf * 2 + a2;
            __builtin_amdgcn_sched_barrier(0);
            float v[16];
#pragma unroll
            for (int i = 0; i < 16; ++i) v[i] = acc[a][bq][i];
            if (rope) {
              const int pos = (a2 == 0) ? (t >> 6) : (t & 63);
              const float2* tb = (const float2*)p.tab + pos * 16;
#pragma unroll
              for (int i = 0; i < 8; ++i) {
                const int f = (i & 3) + 8 * (i >> 2) + 4 * hh;
                const float2 cs = tb[f];
                const float x0 = v[i], x1 = v[i + 8];
                v[i] = x0 * cs.x - x1 * cs.y;
                v[i + 8] = x1 * cs.x + x0 * cs.y;
              }
            }
#pragma unroll
            for (int g = 0; g < 4; ++g) {
              pk[a2 * 4 + g].x = pk2(v[4 * g] * qs, v[4 * g + 1] * qs);
              pk[a2 * 4 + g].y = pk2(v[4 * g + 2] * qs, v[4 * g + 3] * qs);
            }
          }
          stage_store_bf16(lw, lane, pk[0], pk[1], pk[2], pk[3], pk[4], pk[5], pk[6], pk[7],
                           dbase + (size_t)(bq * 32) * DM + hf * 64, DM);
        }
      }
    } else if (EPI == EPI_GU) {
      u16* const dbase = p.act + ((size_t)b * TOKB + jw) * FF + (nw >> 1);
#pragma unroll
      for (int bq = 0; bq < 2; ++bq) {
        uint2 pk[8];
#pragma unroll
        for (int a = 0; a < 4; ++a)
#pragma unroll
          for (int g = 0; g < 2; ++g) {
            const float a0 = silu_f(acc[a][bq][4 * g]) * acc[a][bq][4 * g + 8];
            const float a1 = silu_f(acc[a][bq][4 * g + 1]) * acc[a][bq][4 * g + 9];
            const float a2 = silu_f(acc[a][bq][4 * g + 2]) * acc[a][bq][4 * g + 10];
            const float a3 = silu_f(acc[a][bq][4 * g + 3]) * acc[a][bq][4 * g + 11];
            pk[a * 2 + g].x = pk2(a0, a1);
            pk[a * 2 + g].y = pk2(a2, a3);
          }
        stage_store_bf16(lw, lane, pk[0], pk[1], pk[2], pk[3], pk[4], pk[5], pk[6], pk[7], dbase + (size_t)(bq * 32) * FF, FF);
      }
    } else {
      const bool isctx = jw < 256;
      const size_t ro = isctx ? ((size_t)b * 256 + jw) * DM : ((size_t)b * 2048 + (jw - 256)) * DM;
      const float* const sbase = (isctx ? ea.res_ctx : ea.res_lat) + ro + nw;
      float* const dbase = (isctx ? p.hc : p.out) + ro + nw;
      const float* const gate = p.mod + ((size_t)ea.layer * 17 + (isctx ? 16 : b)) * 6144 + ea.gate_chunk * 1024 + nw;
#pragma unroll
      for (int a = 0; a < 4; ++a)
#pragma unroll
        for (int bq = 0; bq < 2; ++bq)
          stage_res_f32(lw, lane, acc[a][bq], sbase + (size_t)(bq * 32) * DM + a * 32, dbase + (size_t)(bq * 32) * DM + a * 32,
                        gate + a * 32);
    }
    __syncthreads();
    if (EPI == EPI_RES && ns.kind != 0 && gridDim.x == 256) {
      const int c = r * 8 + (int)(blockIdx.x & 7);
      __builtin_amdgcn_fence(__ATOMIC_RELEASE, "agent");
      __syncthreads();
      if (tid == 0) {
        __hip_atomic_fetch_add(cnt + c, 1, __ATOMIC_RELAXED, __HIP_MEMORY_SCOPE_AGENT);
        while (__hip_atomic_load(cnt + c, __ATOMIC_RELAXED, __HIP_MEMORY_SCOPE_AGENT) < 32) __builtin_amdgcn_s_sleep(4);
      }
      __syncthreads();
      __builtin_amdgcn_fence(__ATOMIC_ACQUIRE, "agent");
      const int sl = (int)(blockIdx.x >> 3);
#pragma unroll 2
      for (int q = 0; q < 8; ++q) {
        const int rr = sl * 64 + w * 8 + q;
        const int mi2 = c * 8 + (rr >> 8);
        const int mt2 = lat_only ? (mi2 >> 3) * 9 + 1 + (mi2 & 7) : mi2;
        norm_one_row(p, ns, mt2 * 256 + (rr & 255), lane);
      }
    }
    RD(buf0, 0, FA);
  }
#undef SETP
  __syncthreads();
  TAIL_WORK();
#undef TAIL_WORK
#undef GLDS
#undef GLDS_X
#undef GLDS_W
#undef GL1
#undef RD
#undef MM1
#undef MM7
#undef ITEM
}

DI float halfmax(float x) {
  const unsigned u = __builtin_bit_cast(unsigned, x);
  const auto r = __builtin_amdgcn_permlane32_swap(u, u, false, false);
  return fmaxf(__builtin_bit_cast(float, (unsigned)r[0]), __builtin_bit_cast(float, (unsigned)r[1]));
}
DI float halfsum(float x) {
  const unsigned u = __builtin_bit_cast(unsigned, x);
  const auto r = __builtin_amdgcn_permlane32_swap(u, u, false, false);
  return __builtin_bit_cast(float, (unsigned)r[0]) + __builtin_bit_cast(float, (unsigned)r[1]);
}

struct VFrag4 { bf16x8 f0, f1, f2, f3; };
template <int ND>
DI void rd_vgroup(const char* vp, VFrag4& V) {
#define RDV1(d_, dst_)                                                     \
  {                                                                        \
    dst_ = *(const bf16x8*)(vp + (d_) * 32 * 144);                         \
  }
  RDV1(0, V.f0) RDV1(1, V.f1)
  if (ND > 2) { RDV1(2, V.f2) RDV1(3, V.f3) }
#undef RDV1
}
#define PV_GRP(ND_, V_, P_)                          \
  {                                                  \
    O[0] = MFMA(V_.f0, P_, O[0]);                    \
    O[1] = MFMA(V_.f1, P_, O[1]);                    \
    if (ND_ > 2) {                                   \
      O[2 % ND_] = MFMA(V_.f2, P_, O[2 % ND_]);      \
      O[3 % ND_] = MFMA(V_.f3, P_, O[3 % ND_]);      \
    }                                                \
  }
#define PV_ALL(ND_)                                                            \
  {                                                                            \
    VFrag4 vA, vB;                                                             \
    const char* vbase = sb + vfo;                                              \
    __builtin_amdgcn_sched_barrier(0);                                         \
    rd_vgroup<ND_>(vbase, vA);                                                 \
    rd_vgroup<ND_>(vbase + 32, vB);                                            \
    __builtin_amdgcn_sched_barrier(0);                                         \
    PV_GRP(ND_, vA, pf[0][0]);                                                 \
    __builtin_amdgcn_sched_barrier(0);                                         \
    rd_vgroup<ND_>(vbase + 64, vA);                                            \
    __builtin_amdgcn_sched_barrier(0);                                         \
    PV_GRP(ND_, vB, pf[0][1]);                                                 \
    __builtin_amdgcn_sched_barrier(0);                                         \
    rd_vgroup<ND_>(vbase + 96, vB);                                            \
    __builtin_amdgcn_sched_barrier(0);                                         \
    PV_GRP(ND_, vA, pf[1][0]);                                                 \
    __builtin_amdgcn_sched_barrier(0);                                         \
    PV_GRP(ND_, vB, pf[1][1]);                                                 \
    __builtin_amdgcn_sched_barrier(0);                                         \
  }

template <int NA>
DI void attn_item(const int wv, const Params& p, int b, int hsel, int qj0, int nsteps, int qrow, char* smem) {
  constexpr int KWB = NA ? 512 : 256;
  constexpr int VR = NA ? 256 : 128;
  constexpr int KSZ = 64 * KWB;
  constexpr int BUFSZ = KSZ + VR * 144;
  constexpr int NL = NA ? 4 : 2;
  constexpr int DT = NA ? 2 : 4;
  const int lane = lane_id_(), w = wv, tid = w * 64 + lane, l31 = lane & 31, hh = lane >> 5;
  const int sub = w >> 1;
  const int par = w & 1;
  const int qg = NA ? par : sub;
  const int j = qj0 + qg * 32 + l31;
  const int qcol = NA ? (hsel * 4 + sub) * 64 : hsel * 128 + par * 64;
  const int cb = NA ? sub * 8 : par * 8;
  const int vb = NA ? sub * 64 : 0;
  const int kcol0 = NA ? hsel * 256 : hsel * 128;
  const int vrow0 = kcol0;
  int rs = 0;
  if (NA) { rs = qrow - 4; rs = rs < 0 ? 0 : (rs > 24 ? 24 : rs); }

  bf16x8 qf[4];
  {
    const u16* qp = p.q + ((size_t)b * TOKB + j) * DM + qcol + hh * 8;
#pragma unroll
    for (int ks = 0; ks < 4; ++ks) qf[ks] = *(const bf16x8*)(qp + ks * 16);
  }
  const int kc = NA ? (tid & 31) : (tid & 15);
  const int kr = NA ? (tid >> 5) : (tid >> 4);
  constexpr int KRS = NA ? 16 : 32;
  const u16* kg = p.k + ((size_t)b * TOKB + kr) * DM + kcol0 + kc * 8;
  const unsigned kst = kr * KWB + ((kc ^ (kr & 15)) << 4);
  const int vc = tid & 7, vr = tid >> 3;
  const u16* vg = p.vt + ((size_t)b * 1024 + vrow0 + vr) * TOKB + vc * 8;
  const unsigned vst = KSZ + vr * 144 + (vc >> 1) * 32 + (vc & 1) * 8;
  uint4 rk0, rk1, rk2, rk3, rv0, rv1, rv2, rv3;
  rk2 = rk3 = rv2 = rv3 = make_uint4(0, 0, 0, 0);
#define GLOAD(t_)                                                                         \
  {                                                                                       \
    const int tt_ = (t_);                                                                 \
    const int key0 = NA ? (tt_ < 4 ? tt_ * 64 : 256 + (rs + tt_ - 4) * 64) : tt_ * 64;    \
    rk0 = *(const uint4*)(kg + (size_t)(key0) * DM);                                      \
    rk1 = *(const uint4*)(kg + (size_t)(key0 + KRS) * DM);                                \
    if (NL > 2) {                                                                         \
      rk2 = *(const uint4*)(kg + (size_t)(key0 + 2 * KRS) * DM);                          \
      rk3 = *(const uint4*)(kg + (size_t)(key0 + 3 * KRS) * DM);                          \
    }                                                                                     \
    rv0 = *(const uint4*)(vg + key0);                                                     \
    rv1 = *(const uint4*)(vg + (size_t)64 * TOKB + key0);                                 \
    if (NL > 2) {                                                                         \
      rv2 = *(const uint4*)(vg + (size_t)128 * TOKB + key0);                              \
      rv3 = *(const uint4*)(vg + (size_t)192 * TOKB + key0);                              \
    }                                                                                     \
  }

  f32x16 O[DT];
#pragma unroll
  for (int d = 0; d < DT; ++d)
#pragma unroll
    for (int i = 0; i < 16; ++i) O[d][i] = 0.f;
  float m_run = -INFINITY, l_run = 0.f;

  const unsigned kfo = l31 * KWB;
  const unsigned ksw = l31 & 15;
  const unsigned vfo = KSZ + (vb + l31) * 144 + hh * 16;
  const int qc = qg * 32 + l31;
  int cs0 = qc - 8; cs0 = cs0 < 0 ? 0 : (cs0 > 48 ? 48 : cs0);

  GLOAD(0);
  __syncthreads();
  if (NA) {
    float* rl = (float*)(smem + RPB_OFF);
    const float* rg = p.rpb + (size_t)hsel * 4 * 15 * 31;
    for (int e = tid; e < 4 * 15 * 31; e += 512) rl[e] = rg[e];
  }
  for (int t = 0; t < nsteps; ++t) {
    char* sb = smem + (t & 1) * BUFSZ;
    *(uint4*)(sb + kst) = rk0;
    *(uint4*)(sb + kst + KRS * KWB) = rk1;
    if (NL > 2) {
      *(uint4*)(sb + kst + 2 * KRS * KWB) = rk2;
      *(uint4*)(sb + kst + 3 * KRS * KWB) = rk3;
    }
#define VSTORE(i_, r_)                                                        \
    *(uint2*)(sb + vst + (i_) * 64 * 144) = make_uint2((r_).x, (r_).y);       \
    *(uint2*)(sb + vst + (i_) * 64 * 144 + 16) = make_uint2((r_).z, (r_).w);
    VSTORE(0, rv0)
    VSTORE(1, rv1)
    if (NL > 2) {
      VSTORE(2, rv2)
      VSTORE(3, rv3)
    }
    __syncthreads();
    if (t + 1 < nsteps) GLOAD(t + 1);

    f32x16 S[2];
#pragma unroll
    for (int kt = 0; kt < 2; ++kt)
#pragma unroll
      for (int i = 0; i < 16; ++i) S[kt][i] = 0.f;
    {
      bf16x8 kf[2][4];
#pragma unroll
      for (int ks = 0; ks < 4; ++ks)
#pragma unroll
        for (int kt = 0; kt < 2; ++kt)
          kf[kt][ks] = *(const bf16x8*)(sb + kfo + kt * 32 * KWB + (((unsigned)(cb + ks * 2 + hh) ^ ksw) << 4));
      __builtin_amdgcn_sched_barrier(0);
#pragma unroll
      for (int ks = 0; ks < 4; ++ks)
#pragma unroll
        for (int kt = 0; kt < 2; ++kt) S[kt] = MFMA(kf[kt][ks], qf[ks], S[kt]);
      __builtin_amdgcn_sched_barrier(0);
    }
    if (NA) {
      if (t >= 4) {
        const int dr = rs + (t - 4) - qrow + 7;
        const float* bl = (const float*)(smem + RPB_OFF) + (sub * 15 + dr) * 31 + 4 * hh - qc + 15;
        const int d0 = 4 * hh - cs0;
#pragma unroll
        for (int kt = 0; kt < 2; ++kt)
#pragma unroll
          for (int i = 0; i < 16; ++i) {
            const int ci = kt * 32 + (i & 3) + 8 * (i >> 2);
            const bool valid = (unsigned)(d0 + ci) < 16u;
            const float bv = bl[ci];
            S[kt][i] = valid ? S[kt][i] + bv : -INFINITY;
          }
      }
    }
    float mx = S[0][0];
#pragma unroll
    for (int i = 1; i < 16; ++i) mx = fmaxf(mx, S[0][i]);
#pragma unroll
    for (int i = 0; i < 16; ++i) mx = fmaxf(mx, S[1][i]);
    mx = halfmax(mx);
    const bool need = mx > m_run + 5.5f;
    if (__builtin_amdgcn_ballot_w64(need) != 0ull) {
      const float mn = need ? mx : m_run;
      const float alpha = __builtin_amdgcn_exp2f((m_run - mn) * L2E);
      m_run = mn;
      l_run *= alpha;
#pragma unroll
      for (int d = 0; d < DT; ++d)
#pragma unroll
        for (int i = 0; i < 16; ++i) O[d][i] *= alpha;
    }
    const float mL = m_run * L2E;
    float psum = 0.f;
#pragma unroll
    for (int kt = 0; kt < 2; ++kt)
#pragma unroll
      for (int i = 0; i < 16; ++i) {
        float pv = __builtin_amdgcn_exp2f(fmaf(S[kt][i], L2E, -mL));
        S[kt][i] = pv;
        psum += pv;
      }
    l_run += psum;
    bf16x8 pf[2][2];
#pragma unroll
    for (int kt = 0; kt < 2; ++kt)
#pragma unroll
      for (int s = 0; s < 2; ++s) {
        uint4 u;
        u.x = pk2(S[kt][8 * s], S[kt][8 * s + 1]);
        u.y = pk2(S[kt][8 * s + 2], S[kt][8 * s + 3]);
        u.z = pk2(S[kt][8 * s + 4], S[kt][8 * s + 5]);
        u.w = pk2(S[kt][8 * s + 6], S[kt][8 * s + 7]);
        pf[kt][s] = __builtin_bit_cast(bf16x8, u);
      }
    PV_ALL(DT);
  }

  const float lt = halfsum(l_run);
  const float inv = 1.f / lt;
  if (NA) {
    u16* dst = p.xn + ((size_t)b * TOKB + j) * DM + qcol + 4 * hh;
#pragma unroll
    for (int d = 0; d < DT; ++d)
#pragma unroll
      for (int g = 0; g < 4; ++g) {
        uint2 o;
        o.x = pk2(O[d][4 * g] * inv, O[d][4 * g + 1] * inv);
        o.y = pk2(O[d][4 * g + 2] * inv, O[d][4 * g + 3] * inv);
        *(uint2*)(dst + d * 32 + 8 * g) = o;
      }
    __syncthreads();
  } else {
    float* comb = (float*)smem;
    __syncthreads();
    if (par == 1) {
      const float sc = inv * p.lam[0];
#pragma unroll
      for (int d = 0; d < DT; ++d)
#pragma unroll
        for (int i = 0; i < 16; ++i) comb[(sub * 64 + d * 16 + i) * 64 + lane] = O[d][i] * sc;
    }
    __syncthreads();
    if (par == 0) {
      float ss = 0.f;
#pragma unroll
      for (int d = 0; d < DT; ++d)
#pragma unroll
        for (int i = 0; i < 16; ++i) {
          float v = O[d][i] * inv - comb[(sub * 64 + d * 16 + i) * 64 + lane];
          O[d][i] = v;
          ss += v * v;
        }
      ss = halfsum(ss);
      const float rr = rsqrtf(ss * (1.f / 128.f) + 1e-6f) * 0.8f;
      u16* dst = p.xn + ((size_t)b * TOKB + j) * DM + hsel * 128 + 4 * hh;
#pragma unroll
      for (int d = 0; d < DT; ++d)
#pragma unroll
        for (int g = 0; g < 4; ++g) {
          float4 sg = *(const float4*)(p.subln + d * 32 + 8 * g + 4 * hh);
          uint2 o;
          o.x = pk2(O[d][4 * g] * rr * sg.x, O[d][4 * g + 1] * rr * sg.y);
          o.y = pk2(O[d][4 * g + 2] * rr * sg.z, O[d][4 * g + 3] * rr * sg.w);
          *(uint2*)(dst + d * 32 + 8 * g) = o;
        }
    }
    __syncthreads();
  }
}

DI void na_item(const int wv, const Params& p, int b, int head, int r4, char* smem) {
  constexpr int KSZ = 64 * 128;
  constexpr int BUFSZ = KSZ + 64 * 136;
  const int lane = lane_id_(), w = wv, tid = w * 64 + lane, l31 = lane & 31, hh = lane >> 5;
  const int rp = w >> 2, cg = w & 3;
  const int r0 = r4 * 4;
  const int ra = r0 + 2 * rp;
  const int r_q = ra + (l31 >> 4);
  const int qc = cg * 16 + (l31 & 15);
  const int j = 256 + r_q * 64 + qc;
  const int qcol = head * 64;
  int rs_q = r_q - 4; rs_q = rs_q < 0 ? 0 : (rs_q > 24 ? 24 : rs_q);
  int rs_a = ra - 4; rs_a = rs_a < 0 ? 0 : (rs_a > 24 ? 24 : rs_a);
  int rs_b = ra - 3; rs_b = rs_b < 0 ? 0 : (rs_b > 24 ? 24 : rs_b);
  int rs_lo = r0 - 4; rs_lo = rs_lo < 0 ? 0 : (rs_lo > 24 ? 24 : rs_lo);
  int rs_hi = r0 - 1; rs_hi = rs_hi < 0 ? 0 : (rs_hi > 24 ? 24 : rs_hi);
  const int nsteps = 4 + rs_hi + 8 - rs_lo;
  int cs0 = qc - 8; cs0 = cs0 < 0 ? 0 : (cs0 > 48 ? 48 : cs0);
  int cw0 = cg * 16 - 8; cw0 = cw0 < 0 ? 0 : (cw0 > 32 ? 32 : cw0);
  bf16x8 qf[4];
  {
    const u16* qp = p.q + ((size_t)b * TOKB + j) * DM + qcol + hh * 8;
#pragma unroll
    for (int ks = 0; ks < 4; ++ks) qf[ks] = *(const bf16x8*)(qp + ks * 16);
  }
  const int kc = tid & 7, kr = tid >> 3;
  const u16* kg = p.k + ((size_t)b * TOKB + kr) * DM + qcol + kc * 8;
  const unsigned kst = kr * 128 + ((kc ^ ((kr >> 1) & 7)) << 4);
  const u16* vg = p.vt + ((size_t)b * 1024 + qcol + kr) * TOKB + kc * 8;
  const unsigned vst = KSZ + kr * 136 + kc * 16;
  uint4 rk, rv;
#define NGLOAD(t_)                                                              \
  {                                                                             \
    const int tt_ = (t_);                                                       \
    const int key0 = tt_ < 4 ? tt_ * 64 : 256 + (rs_lo + tt_ - 4) * 64;         \
    rk = *(const uint4*)(kg + (size_t)key0 * DM);                               \
    rv = *(const uint4*)(vg + key0);                                            \
  }
  f32x16 O[2];
#pragma unroll
  for (int d = 0; d < 2; ++d)
#pragma unroll
    for (int i = 0; i < 16; ++i) O[d][i] = 0.f;
  float m_run = -INFINITY, l_run = 0.f;
  const unsigned kfo = l31 * 128;
  const unsigned ksw = (l31 >> 1) & 7;
  const unsigned kfo_b = (cw0 + l31) * 128;
  const unsigned ksw_b = ((cw0 + l31) >> 1) & 7;
  const unsigned vfo = KSZ + l31 * 136 + hh * 8;
#define VFRAG(dst_, off_)                                                            \
  {                                                                                  \
    const uint2 lo_ = *(const uint2*)(sb + vfo + (off_));                            \
    const uint2 hi_ = *(const uint2*)(sb + vfo + (off_) + 16);                       \
    dst_ = __builtin_bit_cast(bf16x8, make_uint4(lo_.x, lo_.y, hi_.x, hi_.y));       \
  }
#define SOFTMAX_UPDATE(mx_)                                                          \
  {                                                                                  \
    float mxx_ = halfmax(mx_);                                                       \
    const bool need_ = mxx_ > m_run + 5.5f;                                          \
    if (__builtin_amdgcn_ballot_w64(need_) != 0ull) {                                \
      const float mn_ = need_ ? mxx_ : m_run;                                        \
      const float alpha_ = __builtin_amdgcn_exp2f((m_run - mn_) * L2E);              \
      m_run = mn_;                                                                   \
      l_run *= alpha_;                                                               \
      _Pragma("unroll") for (int d = 0; d < 2; ++d)                                  \
        _Pragma("unroll") for (int i = 0; i < 16; ++i) O[d][i] *= alpha_;            \
    }                                                                                \
  }
#define PACK8(dst_, S_, o_)                                                          \
  {                                                                                  \
    uint4 u_;                                                                        \
    u_.x = pk2(S_[(o_)], S_[(o_) + 1]);     u_.y = pk2(S_[(o_) + 2], S_[(o_) + 3]);  \
    u_.z = pk2(S_[(o_) + 4], S_[(o_) + 5]); u_.w = pk2(S_[(o_) + 6], S_[(o_) + 7]);  \
    dst_ = __builtin_bit_cast(bf16x8, u_);                                           \
  }

  NGLOAD(0);
  __syncthreads();
  {
    float* rl = (float*)(smem + RPB_OFF);
    const float* rg = p.rpb + (size_t)head * 15 * 31;
    for (int e = tid; e < 15 * 31; e += 512) rl[e] = rg[e];
  }
  for (int t = 0; t < nsteps; ++t) {
    char* sb = smem + (t & 1) * BUFSZ;
    *(uint4*)(sb + kst) = rk;
    *(uint2*)(sb + vst) = make_uint2(rv.x, rv.y);
    *(uint2*)(sb + vst + 8) = make_uint2(rv.z, rv.w);
    __syncthreads();
    if (t + 1 < nsteps) NGLOAD(t + 1);
    if (t < 4) {
      f32x16 S[2];
#pragma unroll
      for (int kt = 0; kt < 2; ++kt)
#pragma unroll
        for (int i = 0; i < 16; ++i) S[kt][i] = 0.f;
      {
        bf16x8 kf[2][4];
#pragma unroll
        for (int ks = 0; ks < 4; ++ks)
#pragma unroll
          for (int kt = 0; kt < 2; ++kt)
            kf[kt][ks] = *(const bf16x8*)(sb + kfo + kt * 32 * 128 + (((unsigned)(ks * 2 + hh) ^ ksw) << 4));
        __builtin_amdgcn_sched_barrier(0);
#pragma unroll
        for (int ks = 0; ks < 4; ++ks)
#pragma unroll
          for (int kt = 0; kt < 2; ++kt) S[kt] = MFMA(kf[kt][ks], qf[ks], S[kt]);
        __builtin_amdgcn_sched_barrier(0);
      }
      float mx = S[0][0];
#pragma unroll
      for (int i = 1; i < 16; ++i) mx = fmaxf(mx, S[0][i]);
#pragma unroll
      for (int i = 0; i < 16; ++i) mx = fmaxf(mx, S[1][i]);
      SOFTMAX_UPDATE(mx);
      const float mL = m_run * L2E;
      float psum = 0.f;
#pragma unroll
      for (int kt = 0; kt < 2; ++kt)
#pragma unroll
        for (int i = 0; i < 16; ++i) {
          const float pv = __builtin_amdgcn_exp2f(fmaf(S[kt][i], L2E, -mL));
          S[kt][i] = pv;
          psum += pv;
        }
      l_run += psum;
      bf16x8 p00, p01, p10, p11;
      PACK8(p00, S[0], 0); PACK8(p01, S[0], 8); PACK8(p10, S[1], 0); PACK8(p11, S[1], 8);
      bf16x8 va0, va1, vb0, vb1;
      __builtin_amdgcn_sched_barrier(0);
      VFRAG(va0, 0); VFRAG(va1, 32 * 136); VFRAG(vb0, 32); VFRAG(vb1, 32 * 136 + 32);
      __builtin_amdgcn_sched_barrier(0);
      O[0] = MFMA(va0, p00, O[0]); O[1] = MFMA(va1, p00, O[1]);
      __builtin_amdgcn_sched_barrier(0);
      VFRAG(va0, 64); VFRAG(va1, 32 * 136 + 64);
      __builtin_amdgcn_sched_barrier(0);
      O[0] = MFMA(vb0, p01, O[0]); O[1] = MFMA(vb1, p01, O[1]);
      __builtin_amdgcn_sched_barrier(0);
      VFRAG(vb0, 96); VFRAG(vb1, 32 * 136 + 96);
      __builtin_amdgcn_sched_barrier(0);
      O[0] = MFMA(va0, p10, O[0]); O[1] = MFMA(va1, p10, O[1]);
      O[0] = MFMA(vb0, p11, O[0]); O[1] = MFMA(vb1, p11, O[1]);
      __builtin_amdgcn_sched_barrier(0);
    } else {
      const int krow = rs_lo + t - 4;
      if (krow >= rs_a && krow < rs_b + 8) {
        f32x16 S1;
#pragma unroll
        for (int i = 0; i < 16; ++i) S1[i] = 0.f;
        {
          bf16x8 kf[4];
#pragma unroll
          for (int ks = 0; ks < 4; ++ks)
            kf[ks] = *(const bf16x8*)(sb + kfo_b + (((unsigned)(ks * 2 + hh) ^ ksw_b) << 4));
          __builtin_amdgcn_sched_barrier(0);
#pragma unroll
          for (int ks = 0; ks < 4; ++ks) S1 = MFMA(kf[ks], qf[ks], S1);
          __builtin_amdgcn_sched_barrier(0);
        }
        const bool rowok = (krow >= rs_q) && (krow < rs_q + 8);
        const float* bl = (const float*)(smem + RPB_OFF) + (krow - r_q + 7) * 31 + cw0 + 4 * hh - qc + 15;
        const int d0 = rowok ? (cw0 + 4 * hh - cs0) : 1000;
        float mx = -INFINITY;
#pragma unroll
        for (int i = 0; i < 16; ++i) {
          const int ci = (i & 3) + 8 * (i >> 2);
          const bool valid = (unsigned)(d0 + ci) < 16u;
          const float bv = bl[ci];
          const float sv = valid ? S1[i] + bv : -INFINITY;
          S1[i] = sv;
          mx = fmaxf(mx, sv);
        }
        SOFTMAX_UPDATE(mx);
        const float mL = m_run * L2E;
        float psum = 0.f;
#pragma unroll
        for (int i = 0; i < 16; ++i) {
          const float pv = __builtin_amdgcn_exp2f(fmaf(S1[i], L2E, -mL));
          S1[i] = pv;
          psum += pv;
        }
        l_run += psum;
        bf16x8 p0, p1;
        PACK8(p0, S1, 0); PACK8(p1, S1, 8);
        bf16x8 va0, va1, vb0, vb1;
        const int vo = cw0 * 2;
        __builtin_amdgcn_sched_barrier(0);
        VFRAG(va0, vo); VFRAG(va1, 32 * 136 + vo); VFRAG(vb0, vo + 32); VFRAG(vb1, 32 * 136 + vo + 32);
        __builtin_amdgcn_sched_barrier(0);
        O[0] = MFMA(va0, p0, O[0]); O[1] = MFMA(va1, p0, O[1]);
        O[0] = MFMA(vb0, p1, O[0]); O[1] = MFMA(vb1, p1, O[1]);
        __builtin_amdgcn_sched_barrier(0);
      }
    }
  }
  const float lt = halfsum(l_run);
  const float inv = 1.f / lt;
  u16* dst = p.xn + ((size_t)b * TOKB + j) * DM + qcol + 4 * hh;
#pragma unroll
  for (int d = 0; d < 2; ++d)
#pragma unroll
    for (int g = 0; g < 4; ++g) {
      uint2 o;
      o.x = pk2(O[d][4 * g] * inv, O[d][4 * g + 1] * inv);
      o.y = pk2(O[d][4 * g + 2] * inv, O[d][4 * g + 3] * inv);
      *(uint2*)(dst + d * 32 + 8 * g) = o;
    }
  __syncthreads();
#undef NGLOAD
#undef VFRAG
#undef SOFTMAX_UPDATE
#undef PACK8
}

DI void phase_da(const int wv, const Params& p, char* smem) {
  for (int idx = blockIdx.x; idx < 2304; idx += gridDim.x) {
    if (idx < 2048) {
      const int rd = idx >> 8, i = idx & 255;
      const int pr = rd * 16 + (i & 7) * 2 + (i >> 7);
      const int qb = (i >> 3) & 15;
      attn_item<0>(wv, p, pr >> 3, pr & 7, 256 + qb * 128, 36, 0, smem);
    } else {
      const int i = idx - 2048;
      const int pr = i >> 1, qb = i & 1;
      attn_item<0>(wv, p, pr >> 3, pr & 7, qb * 128, 4, 0, smem);
    }
  }
}

DI void phase_na(const int wv, const Params& p, char* smem) {
  for (int idx = blockIdx.x; idx < 2048; idx += gridDim.x) {
    const int r4 = idx & 7, head = (idx >> 3) & 15, b = idx >> 7;
    na_item(wv, p, b, head, r4, smem);
  }
}

#define XB_TMO      128
#define XB_XCNT(j)  (256  + 64 * (j))
#define XB_XSUB(j)  (1280 + 64 * (j))
#define XB_XGEN(j)  (2304 + 64 * (j))
#define XB_TOP      3328
#define XB_TOPGEN   3392
#define XCD_BAR_WORDS 3456
#define XB_SPIN_CAP (1u << 18)
#define LAS __attribute__((address_space(3)))
DI unsigned xb_ld(unsigned* q)              { return __hip_atomic_load(q, __ATOMIC_RELAXED, __HIP_MEMORY_SCOPE_AGENT); }
DI unsigned xb_add(unsigned* q, unsigned v) { return __hip_atomic_fetch_add(q, v, __ATOMIC_RELAXED, __HIP_MEMORY_SCOPE_AGENT); }
DI unsigned xb_xcc_id() { return (unsigned)__builtin_amdgcn_s_getreg((3 << 11) | 20) & 0xFu; }
#define XB_SPIN(cond, bar) do { unsigned _sp = 0; while (cond) { __builtin_amdgcn_s_sleep(1); \
    if ((++_sp & 255u) == 0u) { if (xb_ld(&(bar)[XB_TMO])) break; if (_sp > XB_SPIN_CAP) { atomicAdd(&(bar)[XB_TMO], 1u); break; } } } } while (0)
struct XcdBarrier { unsigned* bar; unsigned x; volatile LAS unsigned* st; };
DI XcdBarrier xcd_barrier_post(const int wv, unsigned* bar, volatile LAS unsigned* st) {
  XcdBarrier b; b.bar = bar; b.x = xb_xcc_id(); b.st = st;
  if (wv == 0 && lane_id_() == 0) (void)xb_add(&bar[XB_XCNT(b.x)], 1u);
  return b;
}
DI void xcd_barrier_complete(unsigned* bar, unsigned x, unsigned& nloc, unsigned& nx) {
  const unsigned G = gridDim.x * gridDim.y * gridDim.z;
  unsigned sum, cnt, mine, sp = 0u;
  for (;;) {
    sum = 0u; cnt = 0u; mine = 0u;
#pragma unroll
    for (unsigned j = 0; j < 16; ++j) { const unsigned c = xb_ld(&bar[XB_XCNT(j)]); sum += c; cnt += (c > 0u) ? 1u : 0u; mine = (j == x) ? c : mine; }
    if (sum == G) break;
    __builtin_amdgcn_s_sleep(1);
    if ((++sp & 255u) == 0u) { if (xb_ld(&bar[XB_TMO])) break; if (sp > XB_SPIN_CAP) { atomicAdd(&bar[XB_TMO], 1u); break; } }
  }
  nloc = mine > 0u ? mine : 1u; nx = cnt > 0u ? cnt : 1u;
}
DI void xcd_barrier(const int wv, const XcdBarrier& b) {
  asm volatile("s_waitcnt vmcnt(0)" ::: "memory");
  __syncthreads();
  if (wv == 0 && lane_id_() == 0) {
    unsigned* bar = b.bar;
    __builtin_amdgcn_s_waitcnt(0);
    unsigned nloc = b.st[0], nx = b.st[1];
    if (nloc == 0u) { xcd_barrier_complete(bar, b.x, nloc, nx); b.st[0] = nloc; b.st[1] = nx; }
    const unsigned old = xb_add(&bar[XB_XSUB(b.x)], 1u);
    const unsigned gen = old / nloc;
    if (old + 1u == (gen + 1u) * nloc) {
      __builtin_amdgcn_fence(__ATOMIC_RELEASE, "agent");
      asm volatile("s_waitcnt vmcnt(0)" ::: "memory");
      const unsigned og = xb_add(&bar[XB_TOP], 1u);
      const unsigned tg = og / nx;
      if (og + 1u == (tg + 1u) * nx) xb_add(&bar[XB_TOPGEN], 1u);
      else XB_SPIN(xb_ld(&bar[XB_TOPGEN]) == tg, bar);
      __builtin_amdgcn_fence(__ATOMIC_ACQUIRE, "agent");
      xb_add(&bar[XB_XGEN(b.x)], 1u);
      asm volatile("s_waitcnt vmcnt(0)" ::: "memory");
    } else {
      XB_SPIN(xb_ld(&bar[XB_XGEN(b.x)]) == gen, bar);
      __builtin_amdgcn_fence(__ATOMIC_ACQUIRE, "agent");
      asm volatile("s_waitcnt vmcnt(0)" ::: "memory");
    }
  }
  __syncthreads();
}

__global__ void __launch_bounds__(512) fwd_megakernel(Params p, int ph_lo, int ph_hi) {
  __shared__ __attribute__((aligned(16))) char smem[SMEM_BYTES];
  cg::grid_group grid = cg::this_grid();
  const int wv = __builtin_amdgcn_readfirstlane((int)(threadIdx.x >> 6));
  __shared__ uint4 xb_words;
  if (threadIdx.x == 0) xb_words = make_uint4(0u, 0u, 0u, 0u);
  __syncthreads();
  XcdBarrier xb;
  xb.bar = p.bar; xb.x = 0u; xb.st = (volatile LAS unsigned*)&xb_words;
#define RUN_PHASE(n, ...)                                   \
  if (PHON(n) && ph_lo <= (n) && (n) < ph_hi) {             \
    if (DUP_PHASE == (n)) { __VA_ARGS__; grid.sync(); }     \
    __VA_ARGS__;                                            \
    if ((n) + 1 < ph_hi) {                                  \
      if ((n) == 0) { grid.sync(); xb = xcd_barrier_post(wv, p.bar, (volatile LAS unsigned*)&xb_words); } \
      else xcd_barrier(wv, xb);                             \
    }                                                       \
  }
  RUN_PHASE(0, phase_prep(wv, p, smem))
  RUN_PHASE(1, phase_norm(wv, p, p.x, p.ctx, p.norm_mix, 0, 0, 1, false))
  RUN_PHASE(2, { EpiArgs ea; ea.layer = 0; ea.res_lat = nullptr; ea.res_ctx = nullptr; ea.gate_chunk = 0;
                 phase_gemm256<EPI_QKV>(wv, p, ea, p.wqkv_t, p.xn, 1024, 12, 8, 4, false, smem); })
  RUN_PHASE(3, phase_da(wv, p, smem))
  RUN_PHASE(4, { EpiArgs ea; ea.layer = 0; ea.res_lat = p.x; ea.res_ctx = p.ctx; ea.gate_chunk = 2;
                 phase_gemm256<EPI_RES>(wv, p, ea, p.wo_t, p.xn, 1024, 4, 8, 4, false, smem, 1024, 3136); })
  RUN_PHASE(5, phase_norm(wv, p, p.out, p.hc, p.norm_ffn, 0, 3, 4, false))
  RUN_PHASE(6, { EpiArgs ea; ea.layer = 0; ea.res_lat = nullptr; ea.res_ctx = nullptr; ea.gate_chunk = 0;
                 phase_gemm256<EPI_GU>(wv, p, ea, p.wgu_t, p.xn, 1024, 22, 16, 2, false, smem); })
  RUN_PHASE(7, { EpiArgs ea; ea.layer = 0; ea.res_lat = p.out; ea.res_ctx = p.hc; ea.gate_chunk = 5;
                 phase_gemm256<EPI_RES>(wv, p, ea, p.wd_t, p.act, FF, 4, 8, 4, false, smem, 3136, 6272); })
  RUN_PHASE(8, phase_norm(wv, p, p.out, p.hc, p.norm_mix + 1024, 1, 0, 1, false))
  RUN_PHASE(9, { EpiArgs ea; ea.layer = 1; ea.res_lat = nullptr; ea.res_ctx = nullptr; ea.gate_chunk = 0;
                 phase_gemm256<EPI_QKV>(wv, p, ea, p.wqkv_t + (size_t)3072 * 1024, p.xn, 1024, 12, 8, 4, false, smem); })
  RUN_PHASE(10, phase_na(wv, p, smem))
  RUN_PHASE(11, { EpiArgs ea; ea.layer = 1; ea.res_lat = p.out; ea.res_ctx = p.hc; ea.gate_chunk = 2;
                  phase_gemm256<EPI_RES>(wv, p, ea, p.wo_t + (size_t)1024 * 1024, p.xn, 1024, 4, 8, 4, true, smem, 0, 0); })
  RUN_PHASE(12, phase_norm(wv, p, p.out, p.hc, p.norm_ffn + 1024, 1, 3, 4, true))
  RUN_PHASE(13, { EpiArgs ea; ea.layer = 1; ea.res_lat = nullptr; ea.res_ctx = nullptr; ea.gate_chunk = 0;
                  phase_gemm256<EPI_GU>(wv, p, ea, p.wgu_t + (size_t)5632 * 1024, p.xn, 1024, 22, 16, 2, true, smem); })
  RUN_PHASE(14, { EpiArgs ea; ea.layer = 1; ea.res_lat = p.out; ea.res_ctx = p.hc; ea.gate_chunk = 5;
                  phase_gemm256<EPI_RES>(wv, p, ea, p.wd_t + (size_t)1024 * FF, p.act, FF, 4, 8, 4, true, smem, 0, 0); })
  RUN_PHASE(15, phase_final_norm(wv, p))
}

extern "C" void kernel_launch(void* const* d_in, const int* in_sizes, int n_in, void* d_out, int out_size, void* d_ws, size_t ws_size,
                              hipStream_t stream) {
  static int grid_blocks = 0;
  if (!grid_blocks) {
    int dev = 0, cus = 0, per_cu = 0;
    hipGetDevice(&dev);
    hipDeviceGetAttribute(&cus, hipDeviceAttributeMultiprocessorCount, dev);
    hipOccupancyMaxActiveBlocksPerMultiprocessor(&per_cu, fwd_megakernel, 512, 0);
    if (per_cu > 1) per_cu = 1;
    grid_blocks = cus * per_cu;
    if (grid_blocks <= 0) grid_blocks = 256;
  }
  Params p{};
  p.x = (const float*)d_in[0]; p.c = (const float*)d_in[1]; p.ctx = (const float*)d_in[2]; p.c_ctx = (const float*)d_in[3];
  p.ada_w = (const float*)d_in[4]; p.ada_b = (const float*)d_in[5]; p.norm_mix = (const float*)d_in[6]; p.norm_ffn = (const float*)d_in[7];
  p.da_wqkv = (const float*)d_in[8]; p.lq1 = (const float*)d_in[9]; p.lk1 = (const float*)d_in[10]; p.lq2 = (const float*)d_in[11];
  p.lk2 = (const float*)d_in[12]; p.subln = (const float*)d_in[13]; p.da_wo = (const float*)d_in[14]; p.na_wqkv = (const float*)d_in[15];
  p.rpb = (const float*)d_in[16]; p.na_wo = (const float*)d_in[17]; p.w_gu = (const float*)d_in[18]; p.w_dn = (const float*)d_in[19];
  p.norm_final = (const float*)d_in[20];
  p.out = (float*)d_out;
  char* ws = (char*)d_ws;
  size_t off = 0;
  auto take = [&](size_t bytes) { char* r = ws + off; off += (bytes + 255) & ~(size_t)255; return r; };
  p.wqkv_t = (u16*)take((size_t)2 * 3072 * 1024 * 2);
  p.wo_t = (u16*)take((size_t)2 * 1024 * 1024 * 2);
  p.wgu_t = (u16*)take((size_t)2 * 5632 * 1024 * 2);
  p.wd_t = (u16*)take((size_t)2 * 1024 * FF * 2);
  p.mod = (float*)take((size_t)2 * 17 * 6144 * 4);
  p.tab = (float*)take(64 * 16 * 8);
  p.lam = (float*)take(256);
  p.bar = (unsigned*)take((size_t)XCD_BAR_WORDS * 4);
  p.cnt = (int*)take(512);
  p.hc = (float*)take((size_t)4096 * 1024 * 4);
  p.xn = (u16*)take((size_t)MTOT * 1024 * 2);
  p.q = (u16*)take((size_t)MTOT * 1024 * 2);
  p.k = (u16*)take((size_t)MTOT * 1024 * 2);
  p.vt = (u16*)take((size_t)MTOT * 1024 * 2);
  p.act = p.q;
#if MULTI_LAUNCH
  for (int ph = 0; ph < 16; ++ph) {
    int lo = ph, hi = ph + 1;
    void* args[] = {&p, &lo, &hi};
    hipLaunchCooperativeKernel((void*)fwd_megakernel, dim3(grid_blocks), dim3(512), args, 0, stream);
  }
#else
  int lo = 0, hi = 16;
  void* args[] = {&p, &lo, &hi};
  hipError_t e = hipLaunchCooperativeKernel((void*)fwd_megakernel, dim3(grid_blocks), dim3(512), args, 0, stream);
  if (e != hipSuccess) fprintf(stderr, "cooperative launch failed: %s (grid %d)\n", hipGetErrorString(e), grid_blocks);
#endif
}
```

```cpp
#include <hip/hip_runtime.h>
#include <hip/hip_cooperative_groups.h>
#include <cstdio>
namespace cg = cooperative_groups;

typedef unsigned short u16;
typedef __attribute__((ext_vector_type(8))) short bf16x8;
typedef __attribute__((ext_vector_type(4))) short s16x4;
typedef __attribute__((ext_vector_type(16))) float f32x16;
typedef __attribute__((ext_vector_type(2))) __bf16 bf2_t;
typedef __attribute__((ext_vector_type(2))) float f2_t;

#define DI __device__ __forceinline__
#define MFMA(a, b, c) __builtin_amdgcn_mfma_f32_32x32x16_bf16((a), (b), (c), 0, 0, 0)

#ifndef ONLYPH
#define ONLYPH -1
#endif
#define PHON(x) (ONLYPH < 0 || ONLYPH == (x))
#ifndef TNQ
#define TNQ 128
#endif
#ifndef TNR1
#define TNR1 128
#endif
#ifndef DUP_PHASE
#define DUP_PHASE -1
#endif
#ifndef MULTI_LAUNCH
#define MULTI_LAUNCH 0
#endif

constexpr int DM = 1024;
constexpr int TOKB = 2304;
constexpr int MTOT = 16 * TOKB;
constexpr int FF = 2816;
constexpr float L2E = 1.4426950408889634f;
constexpr int RPB_OFF = 135168 + 256;
constexpr int SMEM_BYTES = 135168 + 256 + 7680 + 256;

struct Params {
  const float *x, *c, *ctx, *c_ctx, *ada_w, *ada_b, *norm_mix, *norm_ffn;
  const float *da_wqkv, *lq1, *lk1, *lq2, *lk2, *subln, *da_wo, *na_wqkv, *rpb, *na_wo, *w_gu, *w_dn, *norm_final;
  float* out;
  u16 *wqkv_t, *wo_t, *wgu_t, *wd_t;
  float *mod, *tab, *lam, *hc;
  unsigned* bar;
  int* cnt;
  u16 *xn, *q, *k, *vt, *act;
};

DI int lane_id_() { return (int)__builtin_amdgcn_mbcnt_hi(~0u, __builtin_amdgcn_mbcnt_lo(~0u, 0u)); }
#define TIDX (wv * 64 + lane_id_())

DI unsigned pk2(float a, float b) {
  f2_t v = {a, b};
  bf2_t r = __builtin_convertvector(v, bf2_t);
  return __builtin_bit_cast(unsigned, r);
}
DI float silu_f(float v) { return v * __builtin_amdgcn_rcpf(1.f + __expf(-v)); }

DI void conv_tile(const int wv, const float* __restrict__ src, int K, int N, u16* __restrict__ dst, int perm, int tile, char* smem) {
  float* ts = (float*)smem;
  const int tid = TIDX;
  const int nkt = K >> 6;
  const int kt = tile % nkt, ntile = tile / nkt;
  const int k0 = kt * 64, n0 = ntile * 64;
  __syncthreads();
#pragma unroll
  for (int i = 0; i < 8; ++i) {
    int kk = wv + 8 * i, n = lane_id_();
    ts[kk * 65 + n] = src[(size_t)(k0 + kk) * N + n0 + n];
  }
  __syncthreads();
  const int n = tid >> 3, kc = tid & 7;
  float v[8];
#pragma unroll
  for (int j = 0; j < 8; ++j) v[j] = ts[(kc * 8 + j) * 65 + n];
  int nn = n0 + n;
  if (perm) {
    int half = nn >= FF ? 1 : 0;
    int cc = nn - half * FF;
    nn = (cc >> 4) * 32 + half * 16 + (cc & 15);
  }
  uint4 o;
  o.x = pk2(v[0], v[1]); o.y = pk2(v[2], v[3]); o.z = pk2(v[4], v[5]); o.w = pk2(v[6], v[7]);
  *(uint4*)(dst + (size_t)nn * K + k0 + kc * 8) = o;
}

DI void mod_item(const int wv, const Params& p, int item, char* smem) {
  const int l = item / 96, n0 = (item % 96) * 64;
  float* sc = (float*)smem;
  float* red = (float*)(smem + 81920);
  const int lane = lane_id_(), w = wv, tid = w * 64 + lane;
  __syncthreads();
  for (int e = tid; e < 17 * 1024; e += 512) {
    int r = e >> 10, kk = e & 1023;
    float v = (r < 16) ? p.c[r * 1024 + kk] : p.c_ctx[kk];
    sc[kk * 20 + r] = silu_f(v);
  }
  __syncthreads();
  float acc[17];
#pragma unroll
  for (int r = 0; r < 17; ++r) acc[r] = 0.f;
  const float* wp = p.ada_w + ((size_t)l * 1024 + w * 128) * 6144 + n0 + lane;
#pragma unroll 16
  for (int kk = 0; kk < 128; ++kk) {
    float wv = wp[(size_t)kk * 6144];
    const float4* s4 = (const float4*)(sc + (w * 128 + kk) * 20);
    float4 a0 = s4[0], a1 = s4[1], a2 = s4[2], a3 = s4[3];
    float a16 = sc[(w * 128 + kk) * 20 + 16];
    acc[0] += a0.x * wv; acc[1] += a0.y * wv; acc[2] += a0.z * wv; acc[3] += a0.w * wv;
    acc[4] += a1.x * wv; acc[5] += a1.y * wv; acc[6] += a1.z * wv; acc[7] += a1.w * wv;
    acc[8] += a2.x * wv; acc[9] += a2.y * wv; acc[10] += a2.z * wv; acc[11] += a2.w * wv;
    acc[12] += a3.x * wv; acc[13] += a3.y * wv; acc[14] += a3.z * wv; acc[15] += a3.w * wv;
    acc[16] += a16 * wv;
  }
#pragma unroll
  for (int r = 0; r < 17; ++r) red[(w * 17 + r) * 64 + lane] = acc[r];
  __syncthreads();
  for (int e = tid; e < 17 * 64; e += 512) {
    int r = e >> 6, nl = e & 63;
    float s = 0.f;
#pragma unroll
    for (int ww = 0; ww < 8; ++ww) s += red[(ww * 17 + r) * 64 + nl];
    s += p.ada_b[l * 6144 + n0 + nl];
    p.mod[((size_t)l * 17 + r) * 6144 + n0 + nl] = s;
  }
}

DI void table_item(const int wv, const Params& p) {
  const int tid = TIDX;
  for (int e = tid; e < 3456; e += 512) p.bar[e] = 0u;
  if (tid < 128) p.cnt[tid] = 0;
  for (int e = tid; e < 1024; e += 512) {
    int pos = e >> 4, f = e & 15;
    float freq = powf(10000.f, -(float)f / 16.f);
    float ang = (float)pos * freq;
    float sn, cs;
    sincosf(ang, &sn, &cs);
    p.tab[e * 2] = cs;
    p.tab[e * 2 + 1] = sn;
  }
  if (tid < 64) {
    float a = p.lq1[tid] * p.lk1[tid];
    float b = p.lq2[tid] * p.lk2[tid];
#pragma unroll
    for (int o = 32; o > 0; o >>= 1) { a += __shfl_xor(a, o); b += __shfl_xor(b, o); }
    if (tid == 0) p.lam[0] = expf(a) - expf(b) + 0.2f;
  }
}

DI void conv_list_tile(const int wv, const Params& p, int t, char* smem) {
  const int l = t / 3136;
  t -= l * 3136;
  if (t < 768) {
    conv_tile(wv, l == 0 ? p.da_wqkv : p.na_wqkv, 1024, 3072, p.wqkv_t + (size_t)l * 3072 * 1024, 0, t, smem);
  } else if (t < 1024) {
    conv_tile(wv, l == 0 ? p.da_wo : p.na_wo, 1024, 1024, p.wo_t + (size_t)l * 1024 * 1024, 0, t - 768, smem);
  } else if (t < 2432) {
    conv_tile(wv, p.w_gu + (size_t)l * 1024 * 5632, 1024, 5632, p.wgu_t + (size_t)l * 5632 * 1024, 1, t - 1024, smem);
  } else {
    conv_tile(wv, p.w_dn + (size_t)l * FF * 1024, FF, 1024, p.wd_t + (size_t)l * 1024 * FF, 0, t - 2432, smem);
  }
}

DI void phase_prep(const int wv, const Params& p, char* smem) {
  const int total = 192 + 1 + 1024;
  for (int it = blockIdx.x; it < total; it += gridDim.x) {
    if (it < 192) { mod_item(wv, p, it, smem); continue; }
    if (it == 192) { table_item(wv, p); continue; }
    conv_list_tile(wv, p, it - 193, smem);
  }
}

struct NormSpec {
  int kind;
  const float* gw;
  int layer, ch_shift, ch_scale;
};
DI void norm_one_row(const Params& p, const NormSpec& ns, int row, int lane) {
  const int b = row / TOKB, j = row - b * TOKB;
  float* src = (j < 256) ? p.hc + ((size_t)b * 256 + j) * DM : p.out + ((size_t)b * 2048 + (j - 256)) * DM;
  float4 v[4];
  float ss = 0.f;
#pragma unroll
  for (int i = 0; i < 4; ++i) {
    v[i] = *(const float4*)(src + i * 256 + lane * 4);
    ss += v[i].x * v[i].x + v[i].y * v[i].y + v[i].z * v[i].z + v[i].w * v[i].w;
  }
#pragma unroll
  for (int o = 32; o > 0; o >>= 1) ss += __shfl_xor(ss, o);
  const float r = rsqrtf(ss * (1.f / 1024.f) + 1e-6f);
  if (ns.kind == 1) {
    const int mr = (j < 256) ? 16 : b;
    const float* sh = p.mod + ((size_t)ns.layer * 17 + mr) * 6144 + ns.ch_shift * 1024;
    const float* sc = p.mod + ((size_t)ns.layer * 17 + mr) * 6144 + ns.ch_scale * 1024;
    u16* dst = p.xn + (size_t)row * DM;
#pragma unroll
    for (int i = 0; i < 4; ++i) {
      const int n = i * 256 + lane * 4;
      float4 g = *(const float4*)(ns.gw + n);
      float4 s1 = *(const float4*)(sc + n);
      float4 s0 = *(const float4*)(sh + n);
      float y0 = v[i].x * r * g.x * (1.f + s1.x) + s0.x;
      float y1 = v[i].y * r * g.y * (1.f + s1.y) + s0.y;
      float y2 = v[i].z * r * g.z * (1.f + s1.z) + s0.z;
      float y3 = v[i].w * r * g.w * (1.f + s1.w) + s0.w;
      uint2 o; o.x = pk2(y0, y1); o.y = pk2(y2, y3);
      *(uint2*)(dst + n) = o;
    }
  } else {
#pragma unroll
    for (int i = 0; i < 4; ++i) {
      const int n = i * 256 + lane * 4;
      float4 g = *(const float4*)(ns.gw + n);
      float4 o;
      o.x = v[i].x * r * g.x; o.y = v[i].y * r * g.y; o.z = v[i].z * r * g.z; o.w = v[i].w * r * g.w;
      *(float4*)(src + n) = o;
    }
  }
}

DI void phase_norm(const int wv, const Params& p, const float* __restrict__ lat, const float* __restrict__ cx, const float* __restrict__ gw,
                   int layer, int ch_shift, int ch_scale, bool lat_only) {
  const int lane = lane_id_(), w = wv;
  for (int row0 = blockIdx.x * 32 + w * 4; row0 < MTOT; row0 += gridDim.x * 32) {
    const int b = row0 / TOKB, j = row0 - b * TOKB;
    if (lat_only && j < 256) continue;
    const float* src = (j < 256) ? cx + ((size_t)b * 256 + j) * DM : lat + ((size_t)b * 2048 + (j - 256)) * DM;
    const int mr = (j < 256) ? 16 : b;
    const float* sh = p.mod + ((size_t)layer * 17 + mr) * 6144 + ch_shift * 1024;
    const float* sc = p.mod + ((size_t)layer * 17 + mr) * 6144 + ch_scale * 1024;
    float4 v0[4], v1[4], v2[4], v3[4];
#pragma unroll
    for (int i = 0; i < 4; ++i) v0[i] = *(const float4*)(src + i * 256 + lane * 4);
#pragma unroll
    for (int i = 0; i < 4; ++i) v1[i] = *(const float4*)(src + DM + i * 256 + lane * 4);
#pragma unroll
    for (int i = 0; i < 4; ++i) v2[i] = *(const float4*)(src + 2 * DM + i * 256 + lane * 4);
#pragma unroll
    for (int i = 0; i < 4; ++i) v3[i] = *(const float4*)(src + 3 * DM + i * 256 + lane * 4);
    float s0 = 0.f, s1 = 0.f, s2 = 0.f, s3 = 0.f;
#pragma unroll
    for (int i = 0; i < 4; ++i) {
      s0 += v0[i].x * v0[i].x + v0[i].y * v0[i].y + v0[i].z * v0[i].z + v0[i].w * v0[i].w;
      s1 += v1[i].x * v1[i].x + v1[i].y * v1[i].y + v1[i].z * v1[i].z + v1[i].w * v1[i].w;
      s2 += v2[i].x * v2[i].x + v2[i].y * v2[i].y + v2[i].z * v2[i].z + v2[i].w * v2[i].w;
      s3 += v3[i].x * v3[i].x + v3[i].y * v3[i].y + v3[i].z * v3[i].z + v3[i].w * v3[i].w;
    }
#pragma unroll
    for (int o = 32; o > 0; o >>= 1) { s0 += __shfl_xor(s0, o); s1 += __shfl_xor(s1, o); s2 += __shfl_xor(s2, o); s3 += __shfl_xor(s3, o); }
    const float r0 = rsqrtf(s0 * (1.f / 1024.f) + 1e-6f), r1 = rsqrtf(s1 * (1.f / 1024.f) + 1e-6f);
    const float r2 = rsqrtf(s2 * (1.f / 1024.f) + 1e-6f), r3 = rsqrtf(s3 * (1.f / 1024.f) + 1e-6f);
    u16* dst = p.xn + (size_t)row0 * DM;
#pragma unroll
    for (int i = 0; i < 4; ++i) {
      const int n = i * 256 + lane * 4;
      const float4 g = *(const float4*)(gw + n);
      const float4 c1 = *(const float4*)(sc + n);
      const float4 c0 = *(const float4*)(sh + n);
      const float m0 = g.x * (1.f + c1.x), m1 = g.y * (1.f + c1.y), m2 = g.z * (1.f + c1.z), m3 = g.w * (1.f + c1.w);
      uint2 o;
#define NROW(v_, r_, k_)                                                                   \
      o.x = pk2(v_[i].x * r_ * m0 + c0.x, v_[i].y * r_ * m1 + c0.y);                        \
      o.y = pk2(v_[i].z * r_ * m2 + c0.z, v_[i].w * r_ * m3 + c0.w);                        \
      *(uint2*)(dst + (k_) * DM + n) = o;
      NROW(v0, r0, 0) NROW(v1, r1, 1) NROW(v2, r2, 2) NROW(v3, r3, 3)
#undef NROW
    }
  }
}

DI void phase_final_norm(const int wv, const Params& p) {
  const int lane = lane_id_(), w = wv;
  for (int row0 = blockIdx.x * 16 + w * 2; row0 < 32768; row0 += gridDim.x * 16) {
    float* src = p.out + (size_t)row0 * DM;
    float4 va[4], vb[4];
#pragma unroll
    for (int i = 0; i < 4; ++i) va[i] = *(const float4*)(src + i * 256 + lane * 4);
#pragma unroll
    for (int i = 0; i < 4; ++i) vb[i] = *(const float4*)(src + DM + i * 256 + lane * 4);
    float sa = 0.f, sb2 = 0.f;
#pragma unroll
    for (int i = 0; i < 4; ++i) {
      sa += va[i].x * va[i].x + va[i].y * va[i].y + va[i].z * va[i].z + va[i].w * va[i].w;
      sb2 += vb[i].x * vb[i].x + vb[i].y * vb[i].y + vb[i].z * vb[i].z + vb[i].w * vb[i].w;
    }
#pragma unroll
    for (int o = 32; o > 0; o >>= 1) { sa += __shfl_xor(sa, o); sb2 += __shfl_xor(sb2, o); }
    const float ra = rsqrtf(sa * (1.f / 1024.f) + 1e-6f);
    const float rb = rsqrtf(sb2 * (1.f / 1024.f) + 1e-6f);
#pragma unroll
    for (int i = 0; i < 4; ++i) {
      const int n = i * 256 + lane * 4;
      const float4 g = *(const float4*)(p.norm_final + n);
      float4 o;
      o.x = va[i].x * ra * g.x; o.y = va[i].y * ra * g.y; o.z = va[i].z * ra * g.z; o.w = va[i].w * ra * g.w;
      *(float4*)(src + n) = o;
      o.x = vb[i].x * rb * g.x; o.y = vb[i].y * rb * g.y; o.z = vb[i].z * rb * g.z; o.w = vb[i].w * rb * g.w;
      *(float4*)(src + DM + n) = o;
    }
  }
}

enum { EPI_QKV = 0, EPI_RES = 1, EPI_GU = 2 };

struct EpiArgs {
  int layer;
  const float* res_lat;
  const float* res_ctx;
  int gate_chunk;
};

template <int EPI>
DI void epilogue(const Params& p, const EpiArgs& ea, const f32x16& acc, int n0, int b, int j, int hh) {
  const size_t m = (size_t)b * TOKB + j;
  if (EPI == EPI_QKV) {
    const int part = n0 >> 10, nn = n0 & 1023;
    if (part < 2) {
      float v[16];
#pragma unroll
      for (int i = 0; i < 16; ++i) v[i] = acc[i];
      if (ea.layer == 0 && j >= 256) {
        const int t = j - 256;
        const int pos = ((n0 & 32) == 0) ? (t >> 6) : (t & 63);
        const float2* tb = (const float2*)p.tab + pos * 16;
#pragma unroll
        for (int i = 0; i < 8; ++i) {
          const int f = (i & 3) + 8 * (i >> 2) + 4 * hh;
          float2 cs = tb[f];
          float a = v[i], bb = v[i + 8];
          v[i] = a * cs.x - bb * cs.y;
          v[i + 8] = bb * cs.x + a * cs.y;
        }
      }
      if (part == 0) {
#pragma unroll
        for (int i = 0; i < 16; ++i) v[i] *= 0.125f;
      }
      u16* dst = (part == 0 ? p.q : p.k) + m * DM + nn + 4 * hh;
#pragma unroll
      for (int g = 0; g < 4; ++g) {
        uint2 o; o.x = pk2(v[4 * g], v[4 * g + 1]); o.y = pk2(v[4 * g + 2], v[4 * g + 3]);
        *(uint2*)(dst + 8 * g) = o;
      }
    } else {
      u16* dst = p.vt + ((size_t)b * 1024 + nn + 4 * hh) * TOKB + j;
#pragma unroll
      for (int i = 0; i < 16; ++i) {
        const int rr = (i & 3) + 8 * (i >> 2);
        dst[(size_t)rr * TOKB] = (u16)(pk2(acc[i], 0.f) & 0xffffu);
      }
    }
  } else if (EPI == EPI_RES) {
    const bool isctx = j < 256;
    const size_t ro = isctx ? ((size_t)b * 256 + j) * DM : ((size_t)b * 2048 + (j - 256)) * DM;
    const float* src = (isctx ? ea.res_ctx : ea.res_lat) + ro;
    float* dst = (isctx ? p.hc : p.out) + ro;
    const float* gate = p.mod + ((size_t)ea.layer * 17 + (isctx ? 16 : b)) * 6144 + ea.gate_chunk * 1024;
#pragma unroll
    for (int g = 0; g < 4; ++g) {
      const int n = n0 + 8 * g + 4 * hh;
      float4 hv = *(const float4*)(src + n);
      float4 gt = *(const float4*)(gate + n);
      hv.x += gt.x * acc[4 * g]; hv.y += gt.y * acc[4 * g + 1]; hv.z += gt.z * acc[4 * g + 2]; hv.w += gt.w * acc[4 * g + 3];
      *(float4*)(dst + n) = hv;
    }
  } else {
    u16* dst = p.act + m * FF + (n0 >> 5) * 16 + 4 * hh;
#pragma unroll
    for (int g = 0; g < 2; ++g) {
      float a0 = silu_f(acc[4 * g]) * acc[4 * g + 8];
      float a1 = silu_f(acc[4 * g + 1]) * acc[4 * g + 9];
      float a2 = silu_f(acc[4 * g + 2]) * acc[4 * g + 10];
      float a3 = silu_f(acc[4 * g + 3]) * acc[4 * g + 11];
      uint2 o; o.x = pk2(a0, a1); o.y = pk2(a2, a3);
      *(uint2*)(dst + 8 * g) = o;
    }
  }
}

DI void stage_store_bf16(char* lw, int lane, const uint2 v0, const uint2 v1, const uint2 v2, const uint2 v3, const uint2 v4,
                         const uint2 v5, const uint2 v6, const uint2 v7, u16* gdst, size_t ld) {
  const int l31 = lane & 31, hh = lane >> 5;
  char* wp = lw + l31 * 136 + hh * 8;
  *(uint2*)(wp) = v0;       *(uint2*)(wp + 16) = v1;  *(uint2*)(wp + 32) = v2;  *(uint2*)(wp + 48) = v3;
  *(uint2*)(wp + 64) = v4;  *(uint2*)(wp + 80) = v5;  *(uint2*)(wp + 96) = v6;  *(uint2*)(wp + 112) = v7;
#pragma unroll
  for (int k = 0; k < 4; ++k) {
    const int c = lane + 64 * k;
    const int row = c >> 3, cc = c & 7;
    const uint2 lo = *(const uint2*)(lw + row * 136 + cc * 16);
    const uint2 hi = *(const uint2*)(lw + row * 136 + cc * 16 + 8);
    *(uint4*)(gdst + (size_t)row * ld + cc * 8) = make_uint4(lo.x, lo.y, hi.x, hi.y);
  }
}
DI void stage_res_f32(char* lw, int lane, const f32x16& acc, const float* gsrc, float* gdst, const float* gate) {
  const int l31 = lane & 31, hh = lane >> 5;
  char* wp = lw + l31 * 144 + hh * 16;
#pragma unroll
  for (int g = 0; g < 4; ++g) *(float4*)(wp + g * 32) = make_float4(acc[4 * g], acc[4 * g + 1], acc[4 * g + 2], acc[4 * g + 3]);
#pragma unroll
  for (int k = 0; k < 4; ++k) {
    const int c = lane + 64 * k;
    const int row = c >> 3, cc = c & 7;
    const float4 a = *(const float4*)(lw + row * 144 + cc * 16);
    const float4 gt = *(const float4*)(gate + cc * 4);
    float4 hv = *(const float4*)(gsrc + (size_t)row * DM + cc * 4);
    hv.x += gt.x * a.x; hv.y += gt.y * a.y; hv.z += gt.z * a.z; hv.w += gt.w * a.w;
    *(float4*)(gdst + (size_t)row * DM + cc * 4) = hv;
  }
}

typedef __attribute__((ext_vector_type(4))) unsigned u32x4;
struct Stage { u32x4 x0, x1, x2, x3, w0, w1, w2, w3; };

template <int EPI, int TN>
DI void phase_gemm(const int wv, const Params& p, const EpiArgs& ea, const u16* __restrict__ Wt, const u16* __restrict__ X, const int K, const int ntn,
                   const bool lat_only, char* smem) {
  constexpr int NT2 = TN / 64;
  constexpr int STG = (256 + TN) * 128;
  constexpr int WOFF = 32768;
  const int lane = lane_id_(), w = wv, tid = w * 64 + lane, l31 = lane & 31, hh = lane >> 5;
  const int wm = w & 3, wn = w >> 2;
  const int lc = tid & 7, lr = tid >> 3;
  const int nmt = lat_only ? 128 : 144;
  const int total = nmt * ntn;
  const int nk = K >> 6;
  if ((int)blockIdx.x >= total) return;
  const int my_tiles = (total - (int)blockIdx.x + (int)gridDim.x - 1) / (int)gridDim.x;
  const int nitems = my_tiles * nk;
  const unsigned st_off = lr * 128 + ((lc ^ ((lr >> 1) & 7)) << 4);
  const unsigned sw = (l31 >> 1) & 7;
  const unsigned xr_off = (wm * 64 + l31) * 128;
  const unsigned wr_off = WOFF + (wn * (TN / 2) + l31) * 128;
  char* const buf0 = smem;
  char* const buf1 = smem + STG;

  int lt = blockIdx.x, lko = 0;
  const u16 *xg, *wg;
#define SETP(t_)                                                            \
  {                                                                         \
    const int mi_ = (t_) / ntn, nt_ = (t_) - mi_ * ntn;                     \
    const int mt_ = lat_only ? (mi_ >> 3) * 9 + 1 + (mi_ & 7) : mi_;        \
    xg = X + (size_t)(mt_ * 256 + lr) * K + lc * 8;                         \
    wg = Wt + (size_t)(nt_ * TN + lr) * K + lc * 8;                         \
  }
#define LOADS(s_)                                                           \
  {                                                                         \
    s_.x0 = *(const u32x4*)(xg + lko);                                      \
    s_.x1 = *(const u32x4*)(xg + (size_t)64 * K + lko);                     \
    s_.x2 = *(const u32x4*)(xg + (size_t)128 * K + lko);                    \
    s_.x3 = *(const u32x4*)(xg + (size_t)192 * K + lko);                    \
    s_.w0 = *(const u32x4*)(wg + lko);                                      \
    s_.w1 = *(const u32x4*)(wg + (size_t)64 * K + lko);                     \
    if (TN > 128) {                                                         \
      s_.w2 = *(const u32x4*)(wg + (size_t)128 * K + lko);                  \
      s_.w3 = *(const u32x4*)(wg + (size_t)192 * K + lko);                  \
    }                                                                       \
    lko += 64;                                                              \
    if (lko == K) {                                                         \
      lko = 0;                                                              \
      if (lt + (int)gridDim.x < total) lt += gridDim.x;                     \
      SETP(lt);                                                             \
    }                                                                       \
  }
#define STORES(s_, sb_)                                                     \
  {                                                                         \
    *(u32x4*)((sb_) + st_off) = s_.x0;                                      \
    *(u32x4*)((sb_) + st_off + 8192) = s_.x1;                               \
    *(u32x4*)((sb_) + st_off + 16384) = s_.x2;                              \
    *(u32x4*)((sb_) + st_off + 24576) = s_.x3;                              \
    *(u32x4*)((sb_) + WOFF + st_off) = s_.w0;                               \
    *(u32x4*)((sb_) + WOFF + st_off + 8192) = s_.w1;                        \
    if (TN > 128) {                                                         \
      *(u32x4*)((sb_) + WOFF + st_off + 16384) = s_.w2;                     \
      *(u32x4*)((sb_) + WOFF + st_off + 24576) = s_.w3;                     \
    }                                                                       \
  }
#define RD(sb_, ks_, F_)                                                                        \
  {                                                                                             \
    const unsigned co_ = ((unsigned)((ks_) * 2 + hh) ^ sw) << 4;                                \
    F_.q0 = *(const bf16x8*)((sb_) + xr_off + co_);                                             \
    F_.q1 = *(const bf16x8*)((sb_) + xr_off + 4096 + co_);                                      \
    F_.p0 = *(const bf16x8*)((sb_) + wr_off + co_);                                             \
    F_.p1 = *(const bf16x8*)((sb_) + wr_off + 4096 + co_);                                      \
  }
#define MM(F_)                                                                                  \
  {                                                                                             \
    acc[0][0] = MFMA(F_.p0, F_.q0, acc[0][0]);                                                  \
    acc[0][1] = MFMA(F_.p0, F_.q1, acc[0][1]);                                                  \
    acc[1][0] = MFMA(F_.p1, F_.q0, acc[1][0]);                                                  \
    acc[1][1] = MFMA(F_.p1, F_.q1, acc[1][1]);                                                  \
  }
#define SB __builtin_amdgcn_sched_barrier(0)
#define ITEM(rb_, sset_, wb_)                                                                   \
  {                                                                                             \
    RD(rb_, 0, F0); RD(rb_, 1, F1); SB;                                                         \
    MM(F0); RD(rb_, 2, F2); SB;                                                                 \
    MM(F1); RD(rb_, 3, F3); SB;                                                                 \
    STORES(sset_, wb_); LOADS(sset_); SB;                                                       \
    MM(F2); SB;                                                                                 \
    MM(F3); SB;                                                                                 \
    __syncthreads();                                                                            \
    ++g;                                                                                        \
  }

  static_assert(TN == 128, "wave tile is 64x64");
  struct Frag { bf16x8 p0, p1, q0, q1; };
  Frag F0, F1, F2, F3;
  Stage sA, sB;
  sA.w2 = sA.w3 = sB.w2 = sB.w3 = (u32x4){0u, 0u, 0u, 0u};
  SETP(lt);
  LOADS(sA);
  LOADS(sB);
  __syncthreads();
  STORES(sA, buf0);
  LOADS(sA);
  __syncthreads();
  int g = 0;
  for (int ct = blockIdx.x; ct < total; ct += gridDim.x) {
    f32x16 acc[NT2][2];
#pragma unroll
    for (int a = 0; a < NT2; ++a)
#pragma unroll
      for (int bq = 0; bq < 2; ++bq)
#pragma unroll
        for (int i = 0; i < 16; ++i) acc[a][bq][i] = 0.f;
    for (int kt = 0; kt < nk; kt += 2) {
      ITEM(buf0, sB, buf1);
      ITEM(buf1, sA, buf0);
    }
    const int mi = ct / ntn, nt = ct - mi * ntn;
    const int mt = lat_only ? (mi >> 3) * 9 + 1 + (mi & 7) : mi;
    const int b = mt / 9;
    const int jb = (mt - b * 9) * 256 + wm * 64 + l31;
#pragma unroll
    for (int a = 0; a < NT2; ++a)
#pragma unroll
      for (int bq = 0; bq < 2; ++bq)
        epilogue<EPI>(p, ea, acc[a][bq], nt * TN + wn * (TN / 2) + a * 32, b, jb + bq * 32, hh);
  }
#undef SETP
#undef LOADS
#undef STORES
#undef RD
#undef MM
#undef ITEM
}

DI bool tile_of(int r, int nmt, int NN, int GM, int GN, int& mi, int& nt) {
  if (gridDim.x == 256 && NN == 22) {
    const int x = blockIdx.x & 7, sl = blockIdx.x >> 3;
    const int c = r * 8 + x;
    const int C1 = (nmt >> 3) * 5;
    if (c < C1) {
      const int mg = c / 5, ng = c - mg * 5;
      mi = mg * 8 + (sl >> 2);
      nt = ng * 4 + (sl & 3);
      return true;
    }
    const int c2 = c - C1;
    if (c2 >= (nmt >> 4)) return false;
    mi = c2 * 16 + (sl >> 1);
    nt = 20 + (sl & 1);
    return true;
  }
  if (gridDim.x == 256) {
    const int x = blockIdx.x & 7, sl = blockIdx.x >> 3;
    const int NG = NN / GN;
    const int c = r * 8 + x;
    if (c >= (nmt / GM) * NG) return false;
    const int mg = c / NG, ng = c - mg * NG;
    const int sm = sl / GN;
    mi = mg * GM + sm;
    nt = ng * GN + (sl - sm * GN);
    return true;
  }
  const int t = r * gridDim.x + blockIdx.x;
  if (t >= nmt * NN) return false;
  mi = t / NN;
  nt = t - mi * NN;
  return true;
}

template <int EPI>
DI void phase_gemm256(const int wv, const Params& p, const EpiArgs& ea, const u16* __restrict__ Wt, const u16* __restrict__ X, const int K, const int NN,
                      const int GM, const int GN, const bool lat_only, char* smem, const int tail_lo = 0, const int tail_hi = 0,
                      const NormSpec ns = NormSpec{0, nullptr, 0, 0, 0}, int* cnt = nullptr) {
  constexpr int STG = 65536;
  constexpr int WOFF = 32768;
  const int lane = lane_id_(), w = wv, tid = w * 64 + lane, l31 = lane & 31, hh = lane >> 5;
  const int wm = w & 3, wn = w >> 2;
  const int lc = tid & 7, lr = tid >> 3;
  const int nmt = lat_only ? 128 : 144;
  const int nk = K >> 6;
  int nr = 0;
  {
    int a_, b_;
    while (tile_of(nr, nmt, NN, GM, GN, a_, b_)) ++nr;
  }
  int tw_rank = blockIdx.x, tw_cnt = gridDim.x;
  if (tail_hi > tail_lo && gridDim.x == 256) {
    const int nchunks = (nmt / GM) * (NN / GN);
    const int nrmax = (nchunks + 7) >> 3;
    int nidle = 0, before = 0;
    for (int x = 0; x < 8; ++x) {
      const int nrx = x < nchunks ? (nchunks - x + 7) >> 3 : 0;
      if (nrx < nrmax) { if (x < (int)(blockIdx.x & 7)) ++before; ++nidle; }
    }
    if (nidle > 0) {
      tw_cnt = nidle * 32;
      tw_rank = (nr < nrmax) ? before * 32 + (int)(blockIdx.x >> 3) : -1;
    }
  }
#define TAIL_WORK()                                                                   \
  if (tail_hi > tail_lo && tw_rank >= 0) {                                            \
    for (int tt_ = tail_lo + tw_rank; tt_ < tail_hi; tt_ += tw_cnt) conv_list_tile(wv, p, tt_, smem); \
  }
  if (nr == 0) { TAIL_WORK(); return; }
  const unsigned st_off = lr * 128 + ((lc ^ ((lr >> 1) & 7)) << 4);
  const unsigned sw = (l31 >> 1) & 7;
  const unsigned xr_off = (wm * 64 + l31) * 128;
  const unsigned wr_off = WOFF + (wn * 128 + l31) * 128;
  char* const buf0 = smem;
  char* const buf1 = smem + STG;

  int lrd = 0, lko = 0;
  const u16 *xg, *wg;
  const int gch = (lane & 7) ^ (((lane >> 4) + 4 * w) & 7);
  const unsigned lds_w = w * 1024;
#define SETP(r_)                                                            \
  {                                                                         \
    int mi_, nt_;                                                           \
    tile_of((r_), nmt, NN, GM, GN, mi_, nt_);                               \
    const int mt_ = lat_only ? (mi_ >> 3) * 9 + 1 + (mi_ & 7) : mi_;        \
    xg = X + (size_t)(mt_ * 256 + lr) * K + gch * 8;                        \
    wg = Wt + (size_t)(nt_ * 256 + lr) * K + gch * 8;                       \
  }
#define GL1(g_, l_) __builtin_amdgcn_global_load_lds((const unsigned*)(g_), (unsigned*)(l_), 16, 0, 0)
#define GLDS_X(sb_)                                                         \
  {                                                                         \
    GL1(xg + lko, (sb_) + lds_w);                                           \
    GL1(xg + (size_t)64 * K + lko, (sb_) + lds_w + 8192);                   \
    GL1(xg + (size_t)128 * K + lko, (sb_) + lds_w + 16384);                 \
    GL1(xg + (size_t)192 * K + lko, (sb_) + lds_w + 24576);                 \
  }
#define GLDS_W(sb_)                                                         \
  {                                                                         \
    GL1(wg + lko, (sb_) + WOFF + lds_w);                                    \
    GL1(wg + (size_t)64 * K + lko, (sb_) + WOFF + lds_w + 8192);            \
    GL1(wg + (size_t)128 * K + lko, (sb_) + WOFF + lds_w + 16384);          \
    GL1(wg + (size_t)192 * K + lko, (sb_) + WOFF + lds_w + 24576);          \
    lko += 64;                                                              \
    if (lko == K) {                                                         \
      lko = 0;                                                              \
      if (lrd + 1 < nr) ++lrd;                                              \
      SETP(lrd);                                                            \
    }                                                                       \
  }
#define GLDS(sb_) { GLDS_X(sb_); GLDS_W(sb_); }
#define WAITV0 asm volatile("s_waitcnt vmcnt(0)" ::: "memory")
#define RD(sb_, ks_, F_)                                                                        \
  {                                                                                             \
    const unsigned co_ = ((unsigned)((ks_) * 2 + hh) ^ sw) << 4;                                \
    F_.q0 = *(const bf16x8*)((sb_) + xr_off + co_);                                             \
    F_.q1 = *(const bf16x8*)((sb_) + xr_off + 4096 + co_);                                      \
    F_.p0 = *(const bf16x8*)((sb_) + wr_off + co_);                                             \
    F_.p1 = *(const bf16x8*)((sb_) + wr_off + 4096 + co_);                                      \
    F_.p2 = *(const bf16x8*)((sb_) + wr_off + 8192 + co_);                                      \
    F_.p3 = *(const bf16x8*)((sb_) + wr_off + 12288 + co_);                                     \
  }
#define MM1(F_)                                                                                 \
  {                                                                                             \
    acc[0][0] = MFMA(F_.p0, F_.q0, acc[0][0]);                                                  \
  }
#define MM7(F_)                                                                                 \
  {                                                                                             \
    acc[0][1] = MFMA(F_.p0, F_.q1, acc[0][1]);                                                  \
    acc[1][0] = MFMA(F_.p1, F_.q0, acc[1][0]);                                                  \
    acc[1][1] = MFMA(F_.p1, F_.q1, acc[1][1]);                                                  \
    acc[2][0] = MFMA(F_.p2, F_.q0, acc[2][0]);                                                  \
    acc[2][1] = MFMA(F_.p2, F_.q1, acc[2][1]);                                                  \
    acc[3][0] = MFMA(F_.p3, F_.q0, acc[3][0]);                                                  \
    acc[3][1] = MFMA(F_.p3, F_.q1, acc[3][1]);                                                  \
  }
#define ITEM(rb_, wb_)                                                                          \
  {                                                                                             \
    if (early) GLDS_X(wb_);                                                                     \
    MM1(FA); SB;                                                                                \
    if (early) GLDS_W(wb_);                                                                     \
    RD(rb_, 1, FB); SB; MM7(FA); SB;                                                            \
    if (!early) GLDS_X(wb_);                                                                    \
    MM1(FB); SB;                                                                                \
    if (!early) GLDS_W(wb_);                                                                    \
    RD(rb_, 2, FA); SB; MM7(FB); SB;                                                            \
    MM1(FA); SB; RD(rb_, 3, FB); SB; MM7(FA); SB;                                               \
    WAITV0;                                                                                     \
    __syncthreads();                                                                            \
    MM1(FB); SB; RD(wb_, 0, FA); SB; MM7(FB); SB;                                               \
  }

  struct Frag6 { bf16x8 p0, p1, p2, p3, q0, q1; };
  Frag6 FA, FB;
  const bool early = w < 4;
  SETP(0);
  __syncthreads();
  GLDS(buf0);
  WAITV0;
  __syncthreads();
  RD(buf0, 0, FA);
  for (int r = 0; r < nr; ++r) {
    f32x16 acc[4][2];
#pragma unroll
    for (int a = 0; a < 4; ++a)
#pragma unroll
      for (int bq = 0; bq < 2; ++bq)
#pragma unroll
        for (int i = 0; i < 16; ++i) acc[a][bq][i] = 0.f;
    for (int kt = 0; kt < nk; kt += 2) {
      ITEM(buf0, buf1);
      ITEM(buf1, buf0);
    }
    int mi, nt;
    tile_of(r, nmt, NN, GM, GN, mi, nt);
    const int mt = lat_only ? (mi >> 3) * 9 + 1 + (mi & 7) : mi;
    const int b = mt / 9;
    const int jb = (mt - b * 9) * 256 + wm * 64 + l31;
    char* const lw = buf1 + w * 8192;
    const int jw = (mt - b * 9) * 256 + wm * 64;
    const int nw = nt * 256 + wn * 128;
    if (EPI == EPI_QKV && nw >= 2048) {
#pragma unroll
      for (int a = 0; a < 4; ++a)
#pragma unroll
        for (int bq = 0; bq < 2; ++bq)
          epilogue<EPI>(p, ea, acc[a][bq], nw + a * 32, b, jb + bq * 32, hh);
    } else if (EPI == EPI_QKV) {
      const int part = nw >> 10, nn = nw & 1023;
      const bool rope = (ea.layer == 0) && (jw >= 256);
      const float qs = part == 0 ? 0.125f : 1.f;
      u16* const dbase = (part == 0 ? p.q : p.k) + ((size_t)b * TOKB + jw) * DM + nn;
#pragma unroll
      for (int bq = 0; bq < 2; ++bq) {
        const int t = jw + bq * 32 + l31 - 256;
#pragma unroll
        for (int hf = 0; hf < 2; ++hf) {
          uint2 pk[8];
#pragma unroll
          for (int a2 = 0; a2 < 2; ++a2) {
            const int a = hf * 2 + a2;
            __builtin_amdgcn_sched_barrier(0);
            float v[16];
#pragma unroll
            for (int i = 0; i < 16; ++i) v[i] = acc[a][bq][i];
            if (rope) {
              const int pos = (a2 == 0) ? (t >> 6) : (t & 63);
              const float2* tb = (const float2*)p.tab + pos * 16;
#pragma unroll
              for (int i = 0; i < 8; ++i) {
                const int f = (i & 3) + 8 * (i >> 2) + 4 * hh;
                const float2 cs = tb[f];
                const float x0 = v[i], x1 = v[i + 8];
                v[i] = x0 * cs.x - x1 * cs.y;
                v[i + 8] = x1 * cs.x + x0 * cs.y;
              }
            }
#pragma unroll
            for (int g = 0; g < 4; ++g) {
              pk[a2 * 4 + g].x = pk2(v[4 * g] * qs, v[4 * g + 1] * qs);
              pk[a2 * 4 + g].y = pk2(v[4 * g + 2] * qs, v[4 * g + 3] * qs);
            }
          }
          stage_store_bf16(lw, lane, pk[0], pk[1], pk[2], pk[3], pk[4], pk[5], pk[6], pk[7],
                           dbase + (size_t)(bq * 32) * DM + hf * 64, DM);
        }
      }
    } else if (EPI == EPI_GU) {
      u16* const dbase = p.act + ((size_t)b * TOKB + jw) * FF + (nw >> 1);
#pragma unroll
      for (int bq = 0; bq < 2; ++bq) {
        uint2 pk[8];
#pragma unroll
        for (int a = 0; a < 4; ++a)
#pragma unroll
          for (int g = 0; g < 2; ++g) {
            const float a0 = silu_f(acc[a][bq][4 * g]) * acc[a][bq][4 * g + 8];
            const float a1 = silu_f(acc[a][bq][4 * g + 1]) * acc[a][bq][4 * g + 9];
            const float a2 = silu_f(acc[a][bq][4 * g + 2]) * acc[a][bq][4 * g + 10];
            const float a3 = silu_f(acc[a][bq][4 * g + 3]) * acc[a][bq][4 * g + 11];
            pk[a * 2 + g].x = pk2(a0, a1);
            pk[a * 2 + g].y = pk2(a2, a3);
          }
        stage_store_bf16(lw, lane, pk[0], pk[1], pk[2], pk[3], pk[4], pk[5], pk[6], pk[7], dbase + (size_t)(bq * 32) * FF, FF);
      }
    } else {
      const bool isctx = jw < 256;
      const size_t ro = isctx ? ((size_t)b * 256 + jw) * DM : ((size_t)b * 2048 + (jw - 256)) * DM;
      const float* const sbase = (isctx ? ea.res_ctx : ea.res_lat) + ro + nw;
      float* const dbase = (isctx ? p.hc : p.out) + ro + nw;
      const float* const gate = p.mod + ((size_t)ea.layer * 17 + (isctx ? 16 : b)) * 6144 + ea.gate_chunk * 1024 + nw;
#pragma unroll
      for (int a = 0; a < 4; ++a)
#pragma unroll
        for (int bq = 0; bq < 2; ++bq)
          stage_res_f32(lw, lane, acc[a][bq], sbase + (size_t)(bq * 32) * DM + a * 32, dbase + (size_t)(bq * 32) * DM + a * 32,
                        gate + a * 32);
    }
    __syncthreads();
    if (EPI == EPI_RES && ns.kind != 0 && gridDim.x == 256) {
      const int c = r * 8 + (int)(blockIdx.x & 7);
      __builtin_amdgcn_fence(__ATOMIC_RELEASE, "agent");
      __syncthreads();
      if (tid == 0) {
        __hip_atomic_fetch_add(cnt + c, 1, __ATOMIC_RELAXED, __HIP_MEMORY_SCOPE_AGENT);
        while (__hip_atomic_load(cnt + c, __ATOMIC_RELAXED, __HIP_MEMORY_SCOPE_AGENT) < 32) __builtin_amdgcn_s_sleep(4);
      }
      __syncthreads();
      __builtin_amdgcn_fence(__ATOMIC_ACQUIRE, "agent");
      const int sl = (int)(blockIdx.x >> 3);
#pragma unroll 2
      for (int q = 0; q < 8; ++q) {
        const int rr = sl * 64 + w * 8 + q;
        const int mi2 = c * 8 + (rr >> 8);
        const int mt2 = lat_only ? (mi2 >> 3) * 9 + 1 + (mi2 & 7) : mi2;
        norm_one_row(p, ns, mt2 * 256 + (rr & 255), lane);
      }
    }
    RD(buf0, 0, FA);
  }
#undef SETP
  __syncthreads();
  TAIL_WORK();
#undef TAIL_WORK
#undef GLDS
#undef GLDS_X
#undef GLDS_W
#undef GL1
#undef RD
#undef MM1
#undef MM7
#undef ITEM
}

DI float halfmax(float x) {
  const unsigned u = __builtin_bit_cast(unsigned, x);
  const auto r = __builtin_amdgcn_permlane32_swap(u, u, false, false);
  return fmaxf(__builtin_bit_cast(float, (unsigned)r[0]), __builtin_bit_cast(float, (unsigned)r[1]));
}
DI float halfsum(float x) {
  const unsigned u = __builtin_bit_cast(unsigned, x);
  const auto r = __builtin_amdgcn_permlane32_swap(u, u, false, false);
  return __builtin_bit_cast(float, (unsigned)r[0]) + __builtin_bit_cast(float, (unsigned)r[1]);
}

struct VFrag4 { bf16x8 f0, f1, f2, f3; };
template <int ND>
DI void rd_vgroup(const char* vp, VFrag4& V) {
#define RDV1(d_, dst_)                                                     \
  {                                                                        \
    dst_ = *(const bf16x8*)(vp + (d_) * 32 * 144);                         \
  }
  RDV1(0, V.f0) RDV1(1, V.f1)
  if (ND > 2) { RDV1(2, V.f2) RDV1(3, V.f3) }
#undef RDV1
}
#define PV_GRP(ND_, V_, P_)                          \
  {                                                  \
    O[0] = MFMA(V_.f0, P_, O[0]);                    \
    O[1] = MFMA(V_.f1, P_, O[1]);                    \
    if (ND_ > 2) {                                   \
      O[2 % ND_] = MFMA(V_.f2, P_, O[2 % ND_]);      \
      O[3 % ND_] = MFMA(V_.f3, P_, O[3 % ND_]);      \
    }                                                \
  }
#define PV_ALL(ND_)                                                            \
  {                                                                            \
    VFrag4 vA, vB;                                                             \
    const char* vbase = sb + vfo;                                              \
    __builtin_amdgcn_sched_barrier(0);                                         \
    rd_vgroup<ND_>(vbase, vA);                                                 \
    rd_vgroup<ND_>(vbase + 32, vB);                                            \
    __builtin_amdgcn_sched_barrier(0);                                         \
    PV_GRP(ND_, vA, pf[0][0]);                                                 \
    __builtin_amdgcn_sched_barrier(0);                                         \
    rd_vgroup<ND_>(vbase + 64, vA);                                            \
    __builtin_amdgcn_sched_barrier(0);                                         \
    PV_GRP(ND_, vB, pf[0][1]);                                                 \
    __builtin_amdgcn_sched_barrier(0);                                         \
    rd_vgroup<ND_>(vbase + 96, vB);                                            \
    __builtin_amdgcn_sched_barrier(0);                                         \
    PV_GRP(ND_, vA, pf[1][0]);                                                 \
    __builtin_amdgcn_sched_barrier(0);                                         \
    PV_GRP(ND_, vB, pf[1][1]);                                                 \
    __builtin_amdgcn_sched_barrier(0);                                         \
  }

template <int NA>
DI void attn_item(const int wv, const Params& p, int b, int hsel, int qj0, int nsteps, int qrow, char* smem) {
  constexpr int KWB = NA ? 512 : 256;
  constexpr int VR = NA ? 256 : 128;
  constexpr int KSZ = 64 * KWB;
  constexpr int BUFSZ = KSZ + VR * 144;
  constexpr int NL = NA ? 4 : 2;
  constexpr int DT = NA ? 2 : 4;
  const int lane = lane_id_(), w = wv, tid = w * 64 + lane, l31 = lane & 31, hh = lane >> 5;
  const int sub = w >> 1;
  const int par = w & 1;
  const int qg = NA ? par : sub;
  const int j = qj0 + qg * 32 + l31;
  const int qcol = NA ? (hsel * 4 + sub) * 64 : hsel * 128 + par * 64;
  const int cb = NA ? sub * 8 : par * 8;
  const int vb = NA ? sub * 64 : 0;
  const int kcol0 = NA ? hsel * 256 : hsel * 128;
  const int vrow0 = kcol0;
  int rs = 0;
  if (NA) { rs = qrow - 4; rs = rs < 0 ? 0 : (rs > 24 ? 24 : rs); }

  bf16x8 qf[4];
  {
    const u16* qp = p.q + ((size_t)b * TOKB + j) * DM + qcol + hh * 8;
#pragma unroll
    for (int ks = 0; ks < 4; ++ks) qf[ks] = *(const bf16x8*)(qp + ks * 16);
  }
  const int kc = NA ? (tid & 31) : (tid & 15);
  const int kr = NA ? (tid >> 5) : (tid >> 4);
  constexpr int KRS = NA ? 16 : 32;
  const u16* kg = p.k + ((size_t)b * TOKB + kr) * DM + kcol0 + kc * 8;
  const unsigned kst = kr * KWB + ((kc ^ (kr & 15)) << 4);
  const int vc = tid & 7, vr = tid >> 3;
  const u16* vg = p.vt + ((size_t)b * 1024 + vrow0 + vr) * TOKB + vc * 8;
  const unsigned vst = KSZ + vr * 144 + (vc >> 1) * 32 + (vc & 1) * 8;
  uint4 rk0, rk1, rk2, rk3, rv0, rv1, rv2, rv3;
  rk2 = rk3 = rv2 = rv3 = make_uint4(0, 0, 0, 0);
#define GLOAD(t_)                                                                         \
  {                                                                                       \
    const int tt_ = (t_);                                                                 \
    const int key0 = NA ? (tt_ < 4 ? tt_ * 64 : 256 + (rs + tt_ - 4) * 64) : tt_ * 64;    \
    rk0 = *(const uint4*)(kg + (size_t)(key0) * DM);                                      \
    rk1 = *(const uint4*)(kg + (size_t)(key0 + KRS) * DM);                                \
    if (NL > 2) {                                                                         \
      rk2 = *(const uint4*)(kg + (size_t)(key0 + 2 * KRS) * DM);                          \
      rk3 = *(const uint4*)(kg + (size_t)(key0 + 3 * KRS) * DM);                          \
    }                                                                                     \
    rv0 = *(const uint4*)(vg + key0);                                                     \
    rv1 = *(const uint4*)(vg + (size_t)64 * TOKB + key0);                                 \
    if (NL > 2) {                                                                         \
      rv2 = *(const uint4*)(vg + (size_t)128 * TOKB + key0);                              \
      rv3 = *(const uint4*)(vg + (size_t)192 * TOKB + key0);                              \
    }                                                                                     \
  }

  f32x16 O[DT];
#pragma unroll
  for (int d = 0; d < DT; ++d)
#pragma unroll
    for (int i = 0; i < 16; ++i) O[d][i] = 0.f;
  float m_run = -INFINITY, l_run = 0.f;

  const unsigned kfo = l31 * KWB;
  const unsigned ksw = l31 & 15;
  const unsigned vfo = KSZ + (vb + l31) * 144 + hh * 16;
  const int qc = qg * 32 + l31;
  int cs0 = qc - 8; cs0 = cs0 < 0 ? 0 : (cs0 > 48 ? 48 : cs0);

  GLOAD(0);
  __syncthreads();
  if (NA) {
    float* rl = (float*)(smem + RPB_OFF);
    const float* rg = p.rpb + (size_t)hsel * 4 * 15 * 31;
    for (int e = tid; e < 4 * 15 * 31; e += 512) rl[e] = rg[e];
  }
  for (int t = 0; t < nsteps; ++t) {
    char* sb = smem + (t & 1) * BUFSZ;
    *(uint4*)(sb + kst) = rk0;
    *(uint4*)(sb + kst + KRS * KWB) = rk1;
    if (NL > 2) {
      *(uint4*)(sb + kst + 2 * KRS * KWB) = rk2;
      *(uint4*)(sb + kst + 3 * KRS * KWB) = rk3;
    }
#define VSTORE(i_, r_)                                                        \
    *(uint2*)(sb + vst + (i_) * 64 * 144) = make_uint2((r_).x, (r_).y);       \
    *(uint2*)(sb + vst + (i_) * 64 * 144 + 16) = make_uint2((r_).z, (r_).w);
    VSTORE(0, rv0)
    VSTORE(1, rv1)
    if (NL > 2) {
      VSTORE(2, rv2)
      VSTORE(3, rv3)
    }
    __syncthreads();
    if (t + 1 < nsteps) GLOAD(t + 1);

    f32x16 S[2];
#pragma unroll
    for (int kt = 0; kt < 2; ++kt)
#pragma unroll
      for (int i = 0; i < 16; ++i) S[kt][i] = 0.f;
    {
      bf16x8 kf[2][4];
#pragma unroll
      for (int ks = 0; ks < 4; ++ks)
#pragma unroll
        for (int kt = 0; kt < 2; ++kt)
          kf[kt][ks] = *(const bf16x8*)(sb + kfo + kt * 32 * KWB + (((unsigned)(cb + ks * 2 + hh) ^ ksw) << 4));
      __builtin_amdgcn_sched_barrier(0);
#pragma unroll
      for (int ks = 0; ks < 4; ++ks)
#pragma unroll
        for (int kt = 0; kt < 2; ++kt) S[kt] = MFMA(kf[kt][ks], qf[ks], S[kt]);
      __builtin_amdgcn_sched_barrier(0);
    }
    if (NA) {
      if (t >= 4) {
        const int dr = rs + (t - 4) - qrow + 7;
        const float* bl = (const float*)(smem + RPB_OFF) + (sub * 15 + dr) * 31 + 4 * hh - qc + 15;
        const int d0 = 4 * hh - cs0;
#pragma unroll
        for (int kt = 0; kt < 2; ++kt)
#pragma unroll
          for (int i = 0; i < 16; ++i) {
            const int ci = kt * 32 + (i & 3) + 8 * (i >> 2);
            const bool valid = (unsigned)(d0 + ci) < 16u;
            const float bv = bl[ci];
            S[kt][i] = valid ? S[kt][i] + bv : -INFINITY;
          }
      }
    }
    float mx = S[0][0];
#pragma unroll
    for (int i = 1; i < 16; ++i) mx = fmaxf(mx, S[0][i]);
#pragma unroll
    for (int i = 0; i < 16; ++i) mx = fmaxf(mx, S[1][i]);
    mx = halfmax(mx);
    const bool need = mx > m_run + 5.5f;
    if (__builtin_amdgcn_ballot_w64(need) != 0ull) {
      const float mn = need ? mx : m_run;
      const float alpha = __builtin_amdgcn_exp2f((m_run - mn) * L2E);
      m_run = mn;
      l_run *= alpha;
#pragma unroll
      for (int d = 0; d < DT; ++d)
#pragma unroll
        for (int i = 0; i < 16; ++i) O[d][i] *= alpha;
    }
    const float mL = m_run * L2E;
    float psum = 0.f;
#pragma unroll
    for (int kt = 0; kt < 2; ++kt)
#pragma unroll
      for (int i = 0; i < 16; ++i) {
        float pv = __builtin_amdgcn_exp2f(fmaf(S[kt][i], L2E, -mL));
        S[kt][i] = pv;
        psum += pv;
      }
    l_run += psum;
    bf16x8 pf[2][2];
#pragma unroll
    for (int kt = 0; kt < 2; ++kt)
#pragma unroll
      for (int s = 0; s < 2; ++s) {
        uint4 u;
        u.x = pk2(S[kt][8 * s], S[kt][8 * s + 1]);
        u.y = pk2(S[kt][8 * s + 2], S[kt][8 * s + 3]);
        u.z = pk2(S[kt][8 * s + 4], S[kt][8 * s + 5]);
        u.w = pk2(S[kt][8 * s + 6], S[kt][8 * s + 7]);
        pf[kt][s] = __builtin_bit_cast(bf16x8, u);
      }
    PV_ALL(DT);
  }

  const float lt = halfsum(l_run);
  const float inv = 1.f / lt;
  if (NA) {
    u16* dst = p.xn + ((size_t)b * TOKB + j) * DM + qcol + 4 * hh;
#pragma unroll
    for (int d = 0; d < DT; ++d)
#pragma unroll
      for (int g = 0; g < 4; ++g) {
        uint2 o;
        o.x = pk2(O[d][4 * g] * inv, O[d][4 * g + 1] * inv);
        o.y = pk2(O[d][4 * g + 2] * inv, O[d][4 * g + 3] * inv);
        *(uint2*)(dst + d * 32 + 8 * g) = o;
      }
    __syncthreads();
  } else {
    float* comb = (float*)smem;
    __syncthreads();
    if (par == 1) {
      const float sc = inv * p.lam[0];
#pragma unroll
      for (int d = 0; d < DT; ++d)
#pragma unroll
        for (int i = 0; i < 16; ++i) comb[(sub * 64 + d * 16 + i) * 64 + lane] = O[d][i] * sc;
    }
    __syncthreads();
    if (par == 0) {
      float ss = 0.f;
#pragma unroll
      for (int d = 0; d < DT; ++d)
#pragma unroll
        for (int i = 0; i < 16; ++i) {
          float v = O[d][i] * inv - comb[(sub * 64 + d * 16 + i) * 64 + lane];
          O[d][i] = v;
          ss += v * v;
        }
      ss = halfsum(ss);
      const float rr = rsqrtf(ss * (1.f / 128.f) + 1e-6f) * 0.8f;
      u16* dst = p.xn + ((size_t)b * TOKB + j) * DM + hsel * 128 + 4 * hh;
#pragma unroll
      for (int d = 0; d < DT; ++d)
#pragma unroll
        for (int g = 0; g < 4; ++g) {
          float4 sg = *(const float4*)(p.subln + d * 32 + 8 * g + 4 * hh);
          uint2 o;
          o.x = pk2(O[d][4 * g] * rr * sg.x, O[d][4 * g + 1] * rr * sg.y);
          o.y = pk2(O[d][4 * g + 2] * rr * sg.z, O[d][4 * g + 3] * rr * sg.w);
          *(uint2*)(dst + d * 32 + 8 * g) = o;
        }
    }
    __syncthreads();
  }
}

DI void na_item(const int wv, const Params& p, int b, int head, int r4, char* smem) {
  constexpr int KSZ = 64 * 128;
  constexpr int BUFSZ = KSZ + 64 * 136;
  const int lane = lane_id_(), w = wv, tid = w * 64 + lane, l31 = lane & 31, hh = lane >> 5;
  const int rp = w >> 2, cg = w & 3;
  const int r0 = r4 * 4;
  const int ra = r0 + 2 * rp;
  const int r_q = ra + (l31 >> 4);
  const int qc = cg * 16 + (l31 & 15);
  const int j = 256 + r_q * 64 + qc;
  const int qcol = head * 64;
  int rs_q = r_q - 4; rs_q = rs_q < 0 ? 0 : (rs_q > 24 ? 24 : rs_q);
  int rs_a = ra - 4; rs_a = rs_a < 0 ? 0 : (rs_a > 24 ? 24 : rs_a);
  int rs_b = ra - 3; rs_b = rs_b < 0 ? 0 : (rs_b > 24 ? 24 : rs_b);
  int rs_lo = r0 - 4; rs_lo = rs_lo < 0 ? 0 : (rs_lo > 24 ? 24 : rs_lo);
  int rs_hi = r0 - 1; rs_hi = rs_hi < 0 ? 0 : (rs_hi > 24 ? 24 : rs_hi);
  const int nsteps = 4 + rs_hi + 8 - rs_lo;
  int cs0 = qc - 8; cs0 = cs0 < 0 ? 0 : (cs0 > 48 ? 48 : cs0);
  int cw0 = cg * 16 - 8; cw0 = cw0 < 0 ? 0 : (cw0 > 32 ? 32 : cw0);
  bf16x8 qf[4];
  {
    const u16* qp = p.q + ((size_t)b * TOKB + j) * DM + qcol + hh * 8;
#pragma unroll
    for (int ks = 0; ks < 4; ++ks) qf[ks] = *(const bf16x8*)(qp + ks * 16);
  }
  const int kc = tid & 7, kr = tid >> 3;
  const u16* kg = p.k + ((size_t)b * TOKB + kr) * DM + qcol + kc * 8;
  const unsigned kst = kr * 128 + ((kc ^ ((kr >> 1) & 7)) << 4);
  const u16* vg = p.vt + ((size_t)b * 1024 + qcol + kr) * TOKB + kc * 8;
  const unsigned vst = KSZ + kr * 136 + kc * 16;
  uint4 rk, rv;
#define NGLOAD(t_)                                                              \
  {                                                                             \
    const int tt_ = (t_);                                                       \
    const int key0 = tt_ < 4 ? tt_ * 64 : 256 + (rs_lo + tt_ - 4) * 64;         \
    rk = *(const uint4*)(kg + (size_t)key0 * DM);                               \
    rv = *(const uint4*)(vg + key0);                                            \
  }
  f32x16 O[2];
#pragma unroll
  for (int d = 0; d < 2; ++d)
#pragma unroll
    for (int i = 0; i < 16; ++i) O[d][i] = 0.f;
  float m_run = -INFINITY, l_run = 0.f;
  const unsigned kfo = l31 * 128;
  const unsigned ksw = (l31 >> 1) & 7;
  const unsigned kfo_b = (cw0 + l31) * 128;
  const unsigned ksw_b = ((cw0 + l31) >> 1) & 7;
  const unsigned vfo = KSZ + l31 * 136 + hh * 8;
#define VFRAG(dst_, off_)                                                            \
  {                                                                                  \
    const uint2 lo_ = *(const uint2*)(sb + vfo + (off_));                            \
    const uint2 hi_ = *(const uint2*)(sb + vfo + (off_) + 16);                       \
    dst_ = __builtin_bit_cast(bf16x8, make_uint4(lo_.x, lo_.y, hi_.x, hi_.y));       \
  }
#define SOFTMAX_UPDATE(mx_)                                                          \
  {                                                                                  \
    float mxx_ = halfmax(mx_);                                                       \
    const bool need_ = mxx_ > m_run + 5.5f;                                          \
    if (__builtin_amdgcn_ballot_w64(need_) != 0ull) {                                \
      const float mn_ = need_ ? mxx_ : m_run;                                        \
      const float alpha_ = __builtin_amdgcn_exp2f((m_run - mn_) * L2E);              \
      m_run = mn_;                                                                   \
      l_run *= alpha_;                                                               \
      _Pragma("unroll") for (int d = 0; d < 2; ++d)                                  \
        _Pragma("unroll") for (int i = 0; i < 16; ++i) O[d][i] *= alpha_;            \
    }                                                                                \
  }
#define PACK8(dst_, S_, o_)                                                          \
  {                                                                                  \
    uint4 u_;                                                                        \
    u_.x = pk2(S_[(o_)], S_[(o_) + 1]);     u_.y = pk2(S_[(o_) + 2], S_[(o_) + 3]);  \
    u_.z = pk2(S_[(o_) + 4], S_[(o_) + 5]); u_.w = pk2(S_[(o_) + 6], S_[(o_) + 7]);  \
    dst_ = __builtin_bit_cast(bf16x8, u_);                                           \
  }

  NGLOAD(0);
  __syncthreads();
  {
    float* rl = (float*)(smem + RPB_OFF);
    const float* rg = p.rpb + (size_t)head * 15 * 31;
    for (int e = tid; e < 15 * 31; e += 512) rl[e] = rg[e];
  }
  for (int t = 0; t < nsteps; ++t) {
    char* sb = smem + (t & 1) * BUFSZ;
    *(uint4*)(sb + kst) = rk;
    *(uint2*)(sb + vst) = make_uint2(rv.x, rv.y);
    *(uint2*)(sb + vst + 8) = make_uint2(rv.z, rv.w);
    __syncthreads();
    if (t + 1 < nsteps) NGLOAD(t + 1);
    if (t < 4) {
      f32x16 S[2];
#pragma unroll
      for (int kt = 0; kt < 2; ++kt)
#pragma unroll
        for (int i = 0; i < 16; ++i) S[kt][i] = 0.f;
      {
        bf16x8 kf[2][4];
#pragma unroll
        for (int ks = 0; ks < 4; ++ks)
#pragma unroll
          for (int kt = 0; kt < 2; ++kt)
            kf[kt][ks] = *(const bf16x8*)(sb + kfo + kt * 32 * 128 + (((unsigned)(ks * 2 + hh) ^ ksw) << 4));
        __builtin_amdgcn_sched_barrier(0);
#pragma unroll
        for (int ks = 0; ks < 4; ++ks)
#pragma unroll
          for (int kt = 0; kt < 2; ++kt) S[kt] = MFMA(kf[kt][ks], qf[ks], S[kt]);
        __builtin_amdgcn_sched_barrier(0);
      }
      float mx = S[0][0];
#pragma unroll
      for (int i = 1; i < 16; ++i) mx = fmaxf(mx, S[0][i]);
#pragma unroll
      for (int i = 0; i < 16; ++i) mx = fmaxf(mx, S[1][i]);
      SOFTMAX_UPDATE(mx);
      const float mL = m_run * L2E;
      float psum = 0.f;
#pragma unroll
      for (int kt = 0; kt < 2; ++kt)
#pragma unroll
        for (int i = 0; i < 16; ++i) {
          const float pv = __builtin_amdgcn_exp2f(fmaf(S[kt][i], L2E, -mL));
          S[kt][i] = pv;
          psum += pv;
        }
      l_run += psum;
      bf16x8 p00, p01, p10, p11;
      PACK8(p00, S[0], 0); PACK8(p01, S[0], 8); PACK8(p10, S[1], 0); PACK8(p11, S[1], 8);
      bf16x8 va0, va1, vb0, vb1;
      __builtin_amdgcn_sched_barrier(0);
      VFRAG(va0, 0); VFRAG(va1, 32 * 136); VFRAG(vb0, 32); VFRAG(vb1, 32 * 136 + 32);
      __builtin_amdgcn_sched_barrier(0);
      O[0] = MFMA(va0, p00, O[0]); O[1] = MFMA(va1, p00, O[1]);
      __builtin_amdgcn_sched_barrier(0);
      VFRAG(va0, 64); VFRAG(va1, 32 * 136 + 64);
      __builtin_amdgcn_sched_barrier(0);
      O[0] = MFMA(vb0, p01, O[0]); O[1] = MFMA(vb1, p01, O[1]);
      __builtin_amdgcn_sched_barrier(0);
      VFRAG(vb0, 96); VFRAG(vb1, 32 * 136 + 96);
      __builtin_amdgcn_sched_barrier(0);
      O[0] = MFMA(va0, p10, O[0]); O[1] = MFMA(va1, p10, O[1]);
      O[0] = MFMA(vb0, p11, O[0]); O[1] = MFMA(vb1, p11, O[1]);
      __builtin_amdgcn_sched_barrier(0);
    } else {
      const int krow = rs_lo + t - 4;
      if (krow >= rs_a && krow < rs_b + 8) {
        f32x16 S1;
#pragma unroll
        for (int i = 0; i < 16; ++i) S1[i] = 0.f;
        {
          bf16x8 kf[4];
#pragma unroll
          for (int ks = 0; ks < 4; ++ks)
            kf[ks] = *(const bf16x8*)(sb + kfo_b + (((unsigned)(ks * 2 + hh) ^ ksw_b) << 4));
          __builtin_amdgcn_sched_barrier(0);
#pragma unroll
          for (int ks = 0; ks < 4; ++ks) S1 = MFMA(kf[ks], qf[ks], S1);
          __builtin_amdgcn_sched_barrier(0);
        }
        const bool rowok = (krow >= rs_q) && (krow < rs_q + 8);
        const float* bl = (const float*)(smem + RPB_OFF) + (krow - r_q + 7) * 31 + cw0 + 4 * hh - qc + 15;
        const int d0 = rowok ? (cw0 + 4 * hh - cs0) : 1000;
        float mx = -INFINITY;
#pragma unroll
        for (int i = 0; i < 16; ++i) {
          const int ci = (i & 3) + 8 * (i >> 2);
          const bool valid = (unsigned)(d0 + ci) < 16u;
          const float bv = bl[ci];
          const float sv = valid ? S1[i] + bv : -INFINITY;
          S1[i] = sv;
          mx = fmaxf(mx, sv);
        }
        SOFTMAX_UPDATE(mx);
        const float mL = m_run * L2E;
        float psum = 0.f;
#pragma unroll
        for (int i = 0; i < 16; ++i) {
          const float pv = __builtin_amdgcn_exp2f(fmaf(S1[i], L2E, -mL));
          S1[i] = pv;
          psum += pv;
        }
        l_run += psum;
        bf16x8 p0, p1;
        PACK8(p0, S1, 0); PACK8(p1, S1, 8);
        bf16x8 va0, va1, vb0, vb1;
        const int vo = cw0 * 2;
        __builtin_amdgcn_sched_barrier(0);
        VFRAG(va0, vo); VFRAG(va1, 32 * 136 + vo); VFRAG(vb0, vo + 32); VFRAG(vb1, 32 * 136 + vo + 32);
        __builtin_amdgcn_sched_barrier(0);
        O[0] = MFMA(va0, p0, O[0]); O[1] = MFMA(va1, p0, O[1]);
        O[0] = MFMA(vb0, p1, O[0]); O[1] = MFMA(vb1, p1, O[1]);
        __builtin_amdgcn_sched_barrier(0);
      }
    }
  }
  const float lt = halfsum(l_run);
  const float inv = 1.f / lt;
  u16* dst = p.xn + ((size_t)b * TOKB + j) * DM + qcol + 4 * hh;
#pragma unroll
  for (int d = 0; d < 2; ++d)
#pragma unroll
    for (int g = 0; g < 4; ++g) {
      uint2 o;
      o.x = pk2(O[d][4 * g] * inv, O[d][4 * g + 1] * inv);
      o.y = pk2(O[d][4 * g + 2] * inv, O[d][4 * g + 3] * inv);
      *(uint2*)(dst + d * 32 + 8 * g) = o;
    }
  __syncthreads();
#undef NGLOAD
#undef VFRAG
#undef SOFTMAX_UPDATE
#undef PACK8
}

DI void phase_da(const int wv, const Params& p, char* smem) {
  for (int idx = blockIdx.x; idx < 2304; idx += gridDim.x) {
    if (idx < 2048) {
      const int rd = idx >> 8, i = idx & 255;
      const int pr = rd * 16 + (i & 7) * 2 + (i >> 7);
      const int qb = (i >> 3) & 15;
      attn_item<0>(wv, p, pr >> 3, pr & 7, 256 + qb * 128, 36, 0, smem);
    } else {
      const int i = idx - 2048;
      const int pr = i >> 1, qb = i & 1;
      attn_item<0>(wv, p, pr >> 3, pr & 7, qb * 128, 4, 0, smem);
    }
  }
}

DI void phase_na(const int wv, const Params& p, char* smem) {
  for (int idx = blockIdx.x; idx < 2048; idx += gridDim.x) {
    const int r4 = idx & 7, head = (idx >> 3) & 15, b = idx >> 7;
    na_item(wv, p, b, head, r4, smem);
  }
}

#define XB_TMO      128
#define XB_XCNT(j)  (256  + 64 * (j))
#define XB_XSUB(j)  (1280 + 64 * (j))
#define XB_XGEN(j)  (2304 + 64 * (j))
#define XB_TOP      3328
#define XB_TOPGEN   3392
#define XCD_BAR_WORDS 3456
#define XB_SPIN_CAP (1u << 18)
#define LAS __attribute__((address_space(3)))
DI unsigned xb_ld(unsigned* q)              { return __hip_atomic_load(q, __ATOMIC_RELAXED, __HIP_MEMORY_SCOPE_AGENT); }
DI unsigned xb_add(unsigned* q, unsigned v) { return __hip_atomic_fetch_add(q, v, __ATOMIC_RELAXED, __HIP_MEMORY_SCOPE_AGENT); }
DI unsigned xb_xcc_id() { return (unsigned)__builtin_amdgcn_s_getreg((3 << 11) | 20) & 0xFu; }
#define XB_SPIN(cond, bar) do { unsigned _sp = 0; while (cond) { __builtin_amdgcn_s_sleep(1); \
    if ((++_sp & 255u) == 0u) { if (xb_ld(&(bar)[XB_TMO])) break; if (_sp > XB_SPIN_CAP) { atomicAdd(&(bar)[XB_TMO], 1u); break; } } } } while (0)
struct XcdBarrier { unsigned* bar; unsigned x; volatile LAS unsigned* st; };
DI XcdBarrier xcd_barrier_post(const int wv, unsigned* bar, volatile LAS unsigned* st) {
  XcdBarrier b; b.bar = bar; b.x = xb_xcc_id(); b.st = st;
  if (wv == 0 && lane_id_() == 0) (void)xb_add(&bar[XB_XCNT(b.x)], 1u);
  return b;
}
DI void xcd_barrier_complete(unsigned* bar, unsigned x, unsigned& nloc, unsigned& nx) {
  const unsigned G = gridDim.x * gridDim.y * gridDim.z;
  unsigned sum, cnt, mine, sp = 0u;
  for (;;) {
    sum = 0u; cnt = 0u; mine = 0u;
#pragma unroll
    for (unsigned j = 0; j < 16; ++j) { const unsigned c = xb_ld(&bar[XB_XCNT(j)]); sum += c; cnt += (c > 0u) ? 1u : 0u; mine = (j == x) ? c : mine; }
    if (sum == G) break;
    __builtin_amdgcn_s_sleep(1);
    if ((++sp & 255u) == 0u) { if (xb_ld(&bar[XB_TMO])) break; if (sp > XB_SPIN_CAP) { atomicAdd(&bar[XB_TMO], 1u); break; } }
  }
  nloc = mine > 0u ? mine : 1u; nx = cnt > 0u ? cnt : 1u;
}
DI void xcd_barrier(const int wv, const XcdBarrier& b) {
  asm volatile("s_waitcnt vmcnt(0)" ::: "memory");
  __syncthreads();
  if (wv == 0 && lane_id_() == 0) {
    unsigned* bar = b.bar;
    __builtin_amdgcn_s_waitcnt(0);
    unsigned nloc = b.st[0], nx = b.st[1];
    if (nloc == 0u) { xcd_barrier_complete(bar, b.x, nloc, nx); b.st[0] = nloc; b.st[1] = nx; }
    const unsigned old = xb_add(&bar[XB_XSUB(b.x)], 1u);
    const unsigned gen = old / nloc;
    if (old + 1u == (gen + 1u) * nloc) {
      __builtin_amdgcn_fence(__ATOMIC_RELEASE, "agent");
      asm volatile("s_waitcnt vmcnt(0)" ::: "memory");
      const unsigned og = xb_add(&bar[XB_TOP], 1u);
      const unsigned tg = og / nx;
      if (og + 1u == (tg + 1u) * nx) xb_add(&bar[XB_TOPGEN], 1u);
      else XB_SPIN(xb_ld(&bar[XB_TOPGEN]) == tg, bar);
      __builtin_amdgcn_fence(__ATOMIC_ACQUIRE, "agent");
      xb_add(&bar[XB_XGEN(b.x)], 1u);
      asm volatile("s_waitcnt vmcnt(0)" ::: "memory");
    } else {
      XB_SPIN(xb_ld(&bar[XB_XGEN(b.x)]) == gen, bar);
      __builtin_amdgcn_fence(__ATOMIC_ACQUIRE, "agent");
      asm volatile("s_waitcnt vmcnt(0)" ::: "memory");
    }
  }
  __syncthreads();
}

__global__ void __launch_bounds__(512) fwd_megakernel(Params p, int ph_lo, int ph_hi) {
  __shared__ __attribute__((aligned(16))) char smem[SMEM_BYTES];
  cg::grid_group grid = cg::this_grid();
  const int wv = __builtin_amdgcn_readfirstlane((int)(threadIdx.x >> 6));
  __shared__ uint4 xb_words;
  if (threadIdx.x == 0) xb_words = make_uint4(0u, 0u, 0u, 0u);
  __syncthreads();
  XcdBarrier xb;
  xb.bar = p.bar; xb.x = 0u; xb.st = (volatile LAS unsigned*)&xb_words;
#define RUN_PHASE(n, ...)                                   \
  if (PHON(n) && ph_lo <= (n) && (n) < ph_hi) {             \
    if (DUP_PHASE == (n)) { __VA_ARGS__; grid.sync(); }     \
    __VA_ARGS__;                                            \
    if ((n) + 1 < ph_hi) {                                  \
      if ((n) == 0) { grid.sync(); xb = xcd_barrier_post(wv, p.bar, (volatile LAS unsigned*)&xb_words); } \
      else xcd_barrier(wv, xb);                             \
    }                                                       \
  }
  RUN_PHASE(0, phase_prep(wv, p, smem))
  RUN_PHASE(1, phase_norm(wv, p, p.x, p.ctx, p.norm_mix, 0, 0, 1, false))
  RUN_PHASE(2, { EpiArgs ea; ea.layer = 0; ea.res_lat = nullptr; ea.res_ctx = nullptr; ea.gate_chunk = 0;
                 phase_gemm256<EPI_QKV>(wv, p, ea, p.wqkv_t, p.xn, 1024, 12, 8, 4, false, smem); })
  RUN_PHASE(3, phase_da(wv, p, smem))
  RUN_PHASE(4, { EpiArgs ea; ea.layer = 0; ea.res_lat = p.x; ea.res_ctx = p.ctx; ea.gate_chunk = 2;
                 phase_gemm256<EPI_RES>(wv, p, ea, p.wo_t, p.xn, 1024, 4, 8, 4, false, smem, 1024, 3136); })
  RUN_PHASE(5, phase_norm(wv, p, p.out, p.hc, p.norm_ffn, 0, 3, 4, false))
  RUN_PHASE(6, { EpiArgs ea; ea.layer = 0; ea.res_lat = nullptr; ea.res_ctx = nullptr; ea.gate_chunk = 0;
                 phase_gemm256<EPI_GU>(wv, p, ea, p.wgu_t, p.xn, 1024, 22, 16, 2, false, smem); })
  RUN_PHASE(7, { EpiArgs ea; ea.layer = 0; ea.res_lat = p.out; ea.res_ctx = p.hc; ea.gate_chunk = 5;
                 phase_gemm256<EPI_RES>(wv, p, ea, p.wd_t, p.act, FF, 4, 8, 4, false, smem, 3136, 6272); })
  RUN_PHASE(8, phase_norm(wv, p, p.out, p.hc, p.norm_mix + 1024, 1, 0, 1, false))
  RUN_PHASE(9, { EpiArgs ea; ea.layer = 1; ea.res_lat = nullptr; ea.res_ctx = nullptr; ea.gate_chunk = 0;
                 phase_gemm256<EPI_QKV>(wv, p, ea, p.wqkv_t + (size_t)3072 * 1024, p.xn, 1024, 12, 8, 4, false, smem); })
  RUN_PHASE(10, phase_na(wv, p, smem))
  RUN_PHASE(11, { EpiArgs ea; ea.layer = 1; ea.res_lat = p.out; ea.res_ctx = p.hc; ea.gate_chunk = 2;
                  phase_gemm256<EPI_RES>(wv, p, ea, p.wo_t + (size_t)1024 * 1024, p.xn, 1024, 4, 8, 4, true, smem, 0, 0); })
  RUN_PHASE(12, phase_norm(wv, p, p.out, p.hc, p.norm_ffn + 1024, 1, 3, 4, true))
  RUN_PHASE(13, { EpiArgs ea; ea.layer = 1; ea.res_lat = nullptr; ea.res_ctx = nullptr; ea.gate_chunk = 0;
                  phase_gemm256<EPI_GU>(wv, p, ea, p.wgu_t + (size_t)5632 * 1024, p.xn, 1024, 22, 16, 2, true, smem); })
  RUN_PHASE(14, { EpiArgs ea; ea.layer = 1; ea.res_lat = p.out; ea.res_ctx = p.hc; ea.gate_chunk = 5;
                  phase_gemm256<EPI_RES>(wv, p, ea, p.wd_t + (size_t)1024 * FF, p.act, FF, 4, 8, 4, true, smem, 0, 0); })
  RUN_PHASE(15, phase_final_norm(wv, p))
}

extern "C" void kernel_launch(void* const* d_in, const int* in_sizes, int n_in, void* d_out, int out_size, void* d_ws, size_t ws_size,
                              hipStream_t stream) {
  static int grid_blocks = 0;
  if (!grid_blocks) {
    int dev = 0, cus = 0, per_cu = 0;
    hipGetDevice(&dev);
    hipDeviceGetAttribute(&cus, hipDeviceAttributeMultiprocessorCount, dev);
    hipOccupancyMaxActiveBlocksPerMultiprocessor(&per_cu, fwd_megakernel, 512, 0);
    if (per_cu > 1) per_cu = 1;
    grid_blocks = cus * per_cu;
    if (grid_blocks <= 0) grid_blocks = 256;
  }
  Params p{};
  p.x = (const float*)d_in[0]; p.c = (const float*)d_in[1]; p.ctx = (const float*)d_in[2]; p.c_ctx = (const float*)d_in[3];
  p.ada_w = (const float*)d_in[4]; p.ada_b = (const float*)d_in[5]; p.norm_mix = (const float*)d_in[6]; p.norm_ffn = (const float*)d_in[7];
  p.da_wqkv = (const float*)d_in[8]; p.lq1 = (const float*)d_in[9]; p.lk1 = (const float*)d_in[10]; p.lq2 = (const float*)d_in[11];
  p.lk2 = (const float*)d_in[12]; p.subln = (const float*)d_in[13]; p.da_wo = (const float*)d_in[14]; p.na_wqkv = (const float*)d_in[15];
  p.rpb = (const float*)d_in[16]; p.na_wo = (const float*)d_in[17]; p.w_gu = (const float*)d_in[18]; p.w_dn = (const float*)d_in[19];
  p.norm_final = (const float*)d_in[20];
  p.out = (float*)d_out;
  char* ws = (char*)d_ws;
  size_t off = 0;
  auto take = [&](size_t bytes) { char* r = ws + off; off += (bytes + 255) & ~(size_t)255; return r; };
  p.wqkv_t = (u16*)take((size_t)2 * 3072 * 1024 * 2);
  p.wo_t = (u16*)take((size_t)2 * 1024 * 1024 * 2);
  p.wgu_t = (u16*)take((size_t)2 * 5632 * 1024 * 2);
  p.wd_t = (u16*)take((size_t)2 * 1024 * FF * 2);
  p.mod = (float*)take((size_t)2 * 17 * 6144 * 4);
  p.tab = (float*)take(64 * 16 * 8);
  p.lam = (float*)take(256);
  p.bar = (unsigned*)take((size_t)XCD_BAR_WORDS * 4);
  p.cnt = (int*)take(512);
  p.hc = (float*)take((size_t)4096 * 1024 * 4);
  p.xn = (u16*)take((size_t)MTOT * 1024 * 2);
  p.q = (u16*)take((size_t)MTOT * 1024 * 2);
  p.k = (u16*)take((size_t)MTOT * 1024 * 2);
  p.vt = (u16*)take((size_t)MTOT * 1024 * 2);
  p.act = p.q;
#if MULTI_LAUNCH
  for (int ph = 0; ph < 16; ++ph) {
    int lo = ph, hi = ph + 1;
    void* args[] = {&p, &lo, &hi};
    hipLaunchCooperativeKernel((void*)fwd_megakernel, dim3(grid_blocks), dim3(512), args, 0, stream);
  }
#else
  int lo = 0, hi = 16;
  void* args[] = {&p, &lo, &hi};
  hipError_t e = hipLaunchCooperativeKernel((void*)fwd_megakernel, dim3(grid_blocks), dim3(512), args, 0, stream);
  if (e != hipSuccess) fprintf(stderr, "cooperative launch failed: %s (grid %d)\n", hipGetErrorString(e), grid_blocks);
#endif
}
```
